# Optimizing an MI355X kernel written in HIP

```python
import jax, jax.numpy as jnp
from jax import lax
import numpy as np

D_MODEL = 1024
BATCH = 4
SEQ = 8192
DEPTH = 2
DEC_BATCH = 1
DEC_SEQ = 16384
PAST_LEN = 128

GRID_W = 64
N_MEM = 256
MIX_WIDTH = 3 * D_MODEL // 2
XATTN_WIDTH = D_MODEL // 2
BRANCH_WIDTH = MIX_WIDTH + XATTN_WIDTH
IN_WIDTH = 3 * MIX_WIDTH + XATTN_WIDTH + BRANCH_WIDTH
NA_HEAD_DIM = 64
NA_HEADS = MIX_WIDTH // NA_HEAD_DIM
XATTN_HEADS = 4
XATTN_HEAD_DIM = XATTN_WIDTH // XATTN_HEADS
CONV_WIDTH = 3
NA_WIN_H = 8
NA_WIN_W = 16
NA_QBLOCK_W = 16
NA_KBLOCK_W = NA_QBLOCK_W + NA_WIN_W
N_CONV_LAYERS = (DEPTH + 1) // 2
N_NA_LAYERS = DEPTH // 2
RMS_EPS = 1e-6
NEG_INF = -1e30

kernel_name = 'hybrid_shortconv_natten_memory_encoder'


def rms_norm(x, w):
    x32 = x.astype(jnp.float32)
    y = x32 * lax.rsqrt(jnp.mean(x32 * x32, axis=-1, keepdims=True) + RMS_EPS)
    return (y * w.astype(jnp.float32)).astype(x.dtype)


def short_conv_mixer(b_gate, c_gate, u, conv_w, conv_b):
    seq = u.shape[1]
    half = CONV_WIDTH // 2
    v = jnp.pad(c_gate * u, ((0, 0), (half, half), (0, 0)))
    conv = sum(v[:, j:j + seq] * conv_w[j] for j in range(CONV_WIDTH)) + conv_b
    return b_gate * conv


def _na_column_tables():
    n_cb = GRID_W // NA_QBLOCK_W
    qcol = np.arange(GRID_W).reshape(n_cb, NA_QBLOCK_W)
    kstart = np.clip(np.arange(n_cb) * NA_QBLOCK_W - NA_WIN_W // 2, 0, GRID_W - NA_KBLOCK_W)
    kcol = kstart[:, None] + np.arange(NA_KBLOCK_W)[None, :]
    cstart = np.clip(qcol - NA_WIN_W // 2, 0, GRID_W - NA_WIN_W)
    rel = kcol[:, None, :] - cstart[:, :, None]
    valid = (rel >= 0) & (rel < NA_WIN_W)
    dx = np.clip(kcol[:, None, :] - qcol[:, :, None] + NA_WIN_W - 1, 0, 2 * NA_WIN_W - 2)
    return kcol.astype(np.int32), valid, dx.astype(np.int32)


def neighborhood_attention(q, k, v, rpb):
    bsz, seq = q.shape[0], q.shape[1]
    rows = seq // GRID_W
    win_h = min(NA_WIN_H, rows)
    n_cb = GRID_W // NA_QBLOCK_W
    kcol_np, valid_np, dx_np = _na_column_tables()
    kcol = jnp.asarray(kcol_np)
    mask = jnp.asarray(valid_np)[:, :, None, :]
    dx = jnp.asarray(dx_np)
    scale = NA_HEAD_DIM ** -0.5
    kg = k.reshape(bsz, rows, GRID_W, NA_HEADS, NA_HEAD_DIM)
    vg = v.reshape(bsz, rows, GRID_W, NA_HEADS, NA_HEAD_DIM)
    q_rows = jnp.moveaxis(q.reshape(bsz, rows, GRID_W, NA_HEADS, NA_HEAD_DIM), 1, 0)
    q_rows = q_rows.reshape(rows, bsz, n_cb, NA_QBLOCK_W, NA_HEADS, NA_HEAD_DIM)

    def one_row(args):
        r, q_r = args
        r0 = jnp.clip(r - win_h // 2, 0, rows - win_h)
        k_r = lax.dynamic_slice_in_dim(kg, r0, win_h, axis=1)
        v_r = lax.dynamic_slice_in_dim(vg, r0, win_h, axis=1)
        k_b = k_r[:, :, kcol]
        v_b = v_r[:, :, kcol]
        s = jnp.einsum('bnihd,banjhd->bhniaj', q_r, k_b).astype(jnp.float32) * scale
        dy = r0 + jnp.arange(win_h) - r + NA_WIN_H - 1
        bias = rpb[:, dy[:, None, None, None], dx[None]]
        s = s + jnp.transpose(bias, (0, 2, 3, 1, 4)).astype(jnp.float32)
        s = jnp.where(mask, s, NEG_INF)
        p = jax.nn.softmax(s.reshape(s.shape[:4] + (-1,)), axis=-1).reshape(s.shape)
        o = jnp.einsum('bhniaj,banjhd->bnihd', p.astype(v_b.dtype), v_b)
        return o.reshape(bsz, GRID_W, NA_HEADS, NA_HEAD_DIM)

    out = lax.map(one_row, (jnp.arange(rows), q_rows))
    return jnp.moveaxis(out, 0, 1).reshape(bsz, seq, NA_HEADS * NA_HEAD_DIM)


def memory_attention(q, mem_k, mem_v):
    bsz, seq = q.shape[0], q.shape[1]
    s = jnp.einsum('bshd,bmhd->bhsm', q, mem_k).astype(jnp.float32) * (XATTN_HEAD_DIM ** -0.5)
    p = jax.nn.softmax(s, axis=-1)
    o = jnp.einsum('bhsm,bmhd->bshd', p.astype(mem_v.dtype), mem_v)
    return o.reshape(bsz, seq, XATTN_WIDTH)


def _trunk(x, mem, norm_w, w_in, w_out, mem_norm_w, w_mem_kv, conv_w, conv_b, na_rpb, final_norm_w):
    bsz, seq, _ = x.shape
    splits = [MIX_WIDTH, 2 * MIX_WIDTH, 3 * MIX_WIDTH, 3 * MIX_WIDTH + XATTN_WIDTH]
    for i in range(DEPTH):
        h = rms_norm(x, norm_w[i])
        z = h @ w_in[i]
        p0, p1, p2, q_mem, gate = jnp.split(z, splits, axis=-1)
        if i % 2 == 0:
            mix = short_conv_mixer(p0, p1, p2, conv_w[i // 2], conv_b[i // 2])
        else:
            hs = (bsz, seq, NA_HEADS, NA_HEAD_DIM)
            mix = neighborhood_attention(p0.reshape(hs), p1.reshape(hs), p2.reshape(hs), na_rpb[i // 2])
        mkv = rms_norm(mem, mem_norm_w[i]) @ w_mem_kv[i]
        mk, mv = jnp.split(mkv, 2, axis=-1)
        ms = (mem.shape[0], mem.shape[1], XATTN_HEADS, XATTN_HEAD_DIM)
        xo = memory_attention(q_mem.reshape(bsz, seq, XATTN_HEADS, XATTN_HEAD_DIM), mk.reshape(ms), mv.reshape(ms))
        y = jnp.concatenate([mix, xo], axis=-1) * jax.nn.silu(gate)
        x = x + y @ w_out[i]
    return rms_norm(x, final_norm_w)


def setup_inputs(seed: int = 0) -> dict:
    key = jax.random.key(seed)
    ks = jax.random.split(key, 13)
    f32 = jnp.float32

    def nrm(k, shape, s):
        return jax.random.normal(k, shape, f32) * s

    return {
        'x_prompt': nrm(ks[0], (BATCH, SEQ, D_MODEL), 1.0),
        'x_sample': nrm(ks[1], (DEC_BATCH, DEC_SEQ, D_MODEL), 1.0),
        'mem_prompt': nrm(ks[2], (BATCH, N_MEM, D_MODEL), 1.0),
        'mem_sample': nrm(ks[3], (DEC_BATCH, N_MEM, D_MODEL), 1.0),
        'norm_w': 1.0 + nrm(ks[4], (DEPTH, D_MODEL), 0.02),
        'w_in': nrm(ks[5], (DEPTH, D_MODEL, IN_WIDTH), D_MODEL ** -0.5),
        'w_out': nrm(ks[6], (DEPTH, BRANCH_WIDTH, D_MODEL), BRANCH_WIDTH ** -0.5),
        'mem_norm_w': 1.0 + nrm(ks[7], (DEPTH, D_MODEL), 0.02),
        'w_mem_kv': nrm(ks[8], (DEPTH, D_MODEL, 2 * XATTN_WIDTH), D_MODEL ** -0.5),
        'conv_w': nrm(ks[9], (N_CONV_LAYERS, CONV_WIDTH, MIX_WIDTH), CONV_WIDTH ** -0.5),
        'conv_b': nrm(ks[10], (N_CONV_LAYERS, MIX_WIDTH), 0.02),
        'na_rpb': nrm(ks[11], (N_NA_LAYERS, NA_HEADS, 2 * NA_WIN_H - 1, 2 * NA_WIN_W - 1), 0.1),
        'final_norm_w': 1.0 + nrm(ks[12], (D_MODEL,), 0.02),
    }


def reference(x_prompt, x_sample, mem_prompt, mem_sample, norm_w, w_in, w_out, mem_norm_w, w_mem_kv,
              conv_w, conv_b, na_rpb, final_norm_w):
    y_prompt = _trunk(x_prompt, mem_prompt, norm_w, w_in, w_out, mem_norm_w, w_mem_kv,
                      conv_w, conv_b, na_rpb, final_norm_w)
    y_sample = _trunk(x_sample, mem_sample, norm_w, w_in, w_out, mem_norm_w, w_mem_kv,
                      conv_w, conv_b, na_rpb, final_norm_w)
    return (y_prompt, y_sample)
```

```cpp
#include <hip/hip_runtime.h>
#include <cstdio>
#include <cstdint>
namespace pg8 {
#define PG8_LAS __attribute__((address_space(3)))
typedef unsigned short bf16_t;
typedef short bf16x8 __attribute__((ext_vector_type(8)));
typedef float f32x4 __attribute__((ext_vector_type(4)));
typedef unsigned u32x4 __attribute__((ext_vector_type(4)));
constexpr int BM = 256, BK = 64, HALF = 128, HTB = HALF * BK * 2  , STAGE_BYTES = 8 * HTB, NXCD = 8, WGM = 8;

__host__ __device__ __forceinline__ int lds_byte(int r, int c) { const int st = (r >> 4) * 2 + (c >> 5), rr = r & 15, cc = c & 31, ob = rr * 64 + cc * 2; return st * 1024 + (ob ^ (((ob >> 9) & 1) << 5)); }
__host__ __device__ __forceinline__ void stage_rc(int b, int& R, int& C) { const int st = b / 1024, sb = b % 1024, swz = sb ^ (((sb >> 9) & 1) << 5); R = (st >> 1) * 16 + swz / 64; C = (st & 1) * 32 + (swz % 64) / 2; }
__host__ __device__ __forceinline__ int perm32(int rho) { const int n = rho >> 4, i = rho & 15; return 8 * (i >> 2) + 4 * n + (i & 3); }

struct Unit { int pm, pn; };
struct Gemm { const bf16_t* A; const bf16_t* Bt; int M, N, K; };

struct StaticOrder {
    int nM, nN, nwg, G, c;
    __host__ __device__ void init(int M, int N, int G_, int c_) { nM = M / BM; nN = N / BM; nwg = nM * nN; G = G_; c = c_; }
    __host__ __device__ bool next(int i, Unit& u) const {
        const long L = (long)i * G + c; if (L >= nwg) return false;
        int wgid = (int)L; { const int q = nwg / NXCD, r = nwg % NXCD, xcd = wgid % NXCD, off = wgid / NXCD; wgid = (xcd < r ? xcd * (q + 1) : r * (q + 1) + (xcd - r) * q) + off; }
        const int nig = WGM * nN, gid = wgid / nig, fm = gid * WGM, gsz = (nM - fm) < WGM ? (nM - fm) : WGM;
        u.pm = fm + ((wgid % nig) % gsz); u.pn = (wgid % nig) / gsz; return true;
    }
    __device__ __forceinline__ void a_ready(const Unit&) const {}
    __device__ __forceinline__ void done(const Unit&) const {}
};

__device__ __forceinline__ unsigned cvt_pk_bf16(float lo, float hi) { unsigned r; asm volatile("v_cvt_pk_bf16_f32 %0, %1, %2" : "=v"(r) : "v"(lo), "v"(hi)); return r; }
typedef float f32x2 __attribute__((ext_vector_type(2)));
__device__ __forceinline__ f32x2 gelu_pk(f32x2 v) {
    const f32x2 av = __builtin_elementwise_abs(v), d = av * 0.2316418882f + 1.0f;
    f32x2 t; t.x = __builtin_amdgcn_rcpf(d.x); t.y = __builtin_amdgcn_rcpf(d.y);
    f32x2 q = t * 0.5307027145f + (-0.7265760135f); q = q * t + 0.7107068705f; q = q * t + (-0.142248368f); q = q * t + 0.127414796f; q = q * t;
    const f32x2 s = (v * v) * (-0.72134752044f);
    f32x2 e; e.x = __builtin_amdgcn_exp2f(s.x); e.y = __builtin_amdgcn_exp2f(s.y);
    const f32x2 m = v * (q * e), r = v - m;
    f32x2 o; o.x = v.x < 0.f ? m.x : r.x; o.y = v.y < 0.f ? m.y : r.y; return o;
}

template <int ACT  > struct EpiBf16 {
    static constexpr bool PERM = true, AFTER_DRAIN = false; static_assert(ACT == 0 || ACT == 1, "EpiBf16: ACT is 0 (none) or 1 (gelu_pk)");
    bf16_t* O; int ldc; const float* bias; int split_cols; size_t split_stride; float scale0;
    __device__ __forceinline__ void operator()(const f32x4 (&acc)[2][2][4][2], const Unit& u, int wr, int wc, int fr, int fq) const {
        const int row0 = u.pm * BM + wr * 64 + fr; int colt = u.pn * BM; bf16_t* base = O;
        float sc = 1.f; if (split_cols) { const int t = colt / split_cols; base += (size_t)t * split_stride; colt -= t * split_cols; if (t == 0) sc = scale0; }
        const int col0 = colt + wc * 32 + 8 * fq, bcol0 = u.pn * BM + wc * 32 + 8 * fq;
        f32x4 bv[2][2];
#pragma unroll
        for (int bj = 0; bj < 2; ++bj)
#pragma unroll
            for (int n = 0; n < 2; ++n) bv[bj][n] = bias ? *(const f32x4*)(bias + bcol0 + bj * HALF + 4 * n) : (f32x4){0.f, 0.f, 0.f, 0.f};
#pragma unroll
        for (int ai = 0; ai < 2; ++ai)
#pragma unroll
            for (int m = 0; m < 4; ++m) { bf16_t* rowp = base + (size_t)(row0 + ai * HALF + m * 16) * ldc + col0;
#pragma unroll
                for (int bj = 0; bj < 2; ++bj) { f32x4 v0 = acc[ai][bj][m][0] + bv[bj][0], v1 = acc[ai][bj][m][1] + bv[bj][1];
                    if (ACT == 1) { f32x2 a = gelu_pk((f32x2){v0[0], v0[1]}), b = gelu_pk((f32x2){v0[2], v0[3]}), c = gelu_pk((f32x2){v1[0], v1[1]}), d = gelu_pk((f32x2){v1[2], v1[3]});
                        v0 = (f32x4){a.x, a.y, b.x, b.y}; v1 = (f32x4){c.x, c.y, d.x, d.y}; }
                    v0 = v0 * sc; v1 = v1 * sc; u32x4 w; w.x = cvt_pk_bf16(v0[0], v0[1]); w.y = cvt_pk_bf16(v0[2], v0[3]); w.z = cvt_pk_bf16(v1[0], v1[1]); w.w = cvt_pk_bf16(v1[2], v1[3]);
                    *(u32x4*)(rowp + bj * HALF) = w; } }
    }
};
struct EpiResF32 {
    static constexpr bool PERM = false, AFTER_DRAIN = false;
    const float* base; float* out; int ldc;
    __device__ __forceinline__ void operator()(const f32x4 (&acc)[2][2][4][2], const Unit& u, int wr, int wc, int fr, int fq) const {
        const int row0 = u.pm * BM + wr * 64 + fr, col0 = u.pn * BM + wc * 32 + 4 * fq;
#pragma unroll
        for (int ai = 0; ai < 2; ++ai)
#pragma unroll
            for (int m = 0; m < 4; ++m) { const size_t off = (size_t)(row0 + ai * HALF + m * 16) * ldc + col0;
#pragma unroll
                for (int bj = 0; bj < 2; ++bj)
#pragma unroll
                    for (int n = 0; n < 2; ++n) { const f32x4 bs = *(const f32x4*)(base + off + bj * HALF + n * 16); *(f32x4*)(out + off + bj * HALF + n * 16) = bs + acc[ai][bj][m][n]; }
                if (m & 1) asm volatile("" ::: "memory"); }
    }
};
template <class Epi, class Sched, bool ALIGN_EPI = false, bool SP2 = false>
__device__ __forceinline__ void gemm_phase(PG8_LAS unsigned char* lds, const Gemm g, const Sched& S, const Epi& E, const int tid) {
    const int wid = __builtin_amdgcn_readfirstlane(tid >> 6), lane = tid & 63, wr = wid >> 2, wc = wid & 3, fr = lane & 15, fq = lane >> 4;
    const int K = g.K, nt = K / BK;
    unsigned voffA[2], voffB[2];
#pragma unroll
    for (int i = 0; i < 2; ++i) { int R, C; stage_rc(tid * 16 + i * 8192, R, C); const int Rb = Epi::PERM ? ((R & ~31) + perm32(R & 31)) : R;
        voffA[i] = (unsigned)(R * K + C) * 2u; voffB[i] = (unsigned)(Rb * K + C) * 2u; }
    const size_t kstep = (size_t)(BK * 2);
    const size_t hstep = (size_t)HALF * K * 2;
    const size_t tstep = 2 * hstep;
    const unsigned ldsw = (unsigned)wid * 1024u;
    const int aoff = lds_byte(wr * 64 + fr, fq * 8), boff = lds_byte(wc * 32 + fr, fq * 8);
#define PG8_SA(b, h) (((b) * 2 + (h)) * HTB)
#define PG8_SB(b, h) ((4 + (b) * 2 + (h)) * HTB)
#define PG8_STAGE(bufoff, gbase, voff) do { _Pragma("unroll") for (int _i = 0; _i < 2; ++_i) \
        __builtin_amdgcn_global_load_lds((const unsigned*)((const char*)(gbase) + (voff)[_i]), (PG8_LAS unsigned*)(lds + (bufoff) + ldsw + _i * 8192), 16, 0, 0); } while (0)
#define PG8_LDA(dst, b, h) do { _Pragma("unroll") for (int m = 0; m < 4; ++m) _Pragma("unroll") for (int k = 0; k < 2; ++k) dst[m][k] = *(const PG8_LAS bf16x8*)(lds + PG8_SA(b, h) + aoff + m * 2048 + k * 1024); } while (0)
#define PG8_LDB(dst, b, h) do { _Pragma("unroll") for (int n = 0; n < 2; ++n) _Pragma("unroll") for (int k = 0; k < 2; ++k) dst[n][k] = *(const PG8_LAS bf16x8*)(lds + PG8_SB(b, h) + boff + n * 2048 + k * 1024); } while (0)
#define PG8_MMA(ai, bj, At, Bt) do { __builtin_amdgcn_s_setprio(1); _Pragma("unroll") for (int m = 0; m < 4; ++m) _Pragma("unroll") for (int n = 0; n < 2; ++n) _Pragma("unroll") for (int k = 0; k < 2; ++k) \
        acc[ai][bj][m][n] = __builtin_amdgcn_mfma_f32_16x16x32_bf16(Bt[n][k], At[m][k], acc[ai][bj][m][n], 0, 0, 0); __builtin_amdgcn_s_setprio(0); } while (0)
#define PG8_WAIT_V(n) asm volatile("s_waitcnt vmcnt(" #n ")" ::: "memory")
#define PG8_WAIT_L(n) asm volatile("s_waitcnt lgkmcnt(" #n ")" ::: "memory")
#define PG8_BAR __builtin_amdgcn_s_barrier()
#define PG8_SCHED __builtin_amdgcn_sched_barrier(0)
    Unit cur, nxt; int ui = 0;
    if (!S.next(0, cur)) return;
    f32x4 acc[2][2][4][2];
#pragma unroll
    for (int a = 0; a < 2; ++a)
#pragma unroll
        for (int b = 0; b < 2; ++b)
#pragma unroll
            for (int m = 0; m < 4; ++m)
#pragma unroll
                for (int n = 0; n < 2; ++n) acc[a][b][m][n] = (f32x4){0.f, 0.f, 0.f, 0.f};
    bf16x8 At[4][2], B0[2][2], B1[2][2];
    const char* cA = (const char*)g.A + (size_t)cur.pm * tstep; const char* cB = (const char*)g.Bt + (size_t)cur.pn * tstep;
    S.a_ready(cur);
    if constexpr (SP2) {
        PG8_STAGE(PG8_SB(0, 0), cB, voffB); PG8_STAGE(PG8_SB(0, 1), cB + hstep, voffB); PG8_STAGE(PG8_SA(0, 0), cA, voffA); PG8_STAGE(PG8_SA(0, 1), cA + hstep, voffA);
        if (wr == 1) PG8_BAR;
        PG8_WAIT_V(2); PG8_BAR;
        PG8_STAGE(PG8_SB(1, 0), cB + kstep, voffB); PG8_STAGE(PG8_SA(1, 0), cA + kstep, voffA); PG8_STAGE(PG8_SB(1, 1), cB + hstep + kstep, voffB);
        PG8_WAIT_V(6); PG8_BAR;
    } else {
        PG8_STAGE(PG8_SB(0, 0), cB, voffB); PG8_STAGE(PG8_SA(0, 0), cA, voffA); PG8_STAGE(PG8_SB(0, 1), cB + hstep, voffB); PG8_STAGE(PG8_SA(0, 1), cA + hstep, voffA);
        if (wr == 1) PG8_BAR;
        PG8_WAIT_V(4); PG8_BAR;
        PG8_STAGE(PG8_SB(1, 0), cB + kstep, voffB); PG8_STAGE(PG8_SA(1, 0), cA + kstep, voffA); PG8_STAGE(PG8_SB(1, 1), cB + hstep + kstep, voffB);
        PG8_WAIT_V(6); PG8_BAR;
    }
    for (;;) {
        const bool has_next = S.next(ui + 1, nxt);
        const char* nA = has_next ? (const char*)g.A + (size_t)nxt.pm * tstep : cA; const char* nB = has_next ? (const char*)g.Bt + (size_t)nxt.pn * tstep : cB;
        for (int t = 0; t < nt; t += 2) {
            const bool last = (t == nt - 2);
            const char* a1 = cA + (size_t)(t + 1) * kstep;
            const char* a2 = last ? nA : cA + (size_t)(t + 2) * kstep; const char* b2 = last ? nB : cB + (size_t)(t + 2) * kstep;
            const char* a3 = a2 + kstep; const char* b3 = b2 + kstep;
            if (last && has_next) S.a_ready(nxt);
            if constexpr (SP2) {
            PG8_LDB(B0, 0, 0); PG8_LDB(B1, 0, 1); PG8_SCHED; PG8_LDA(At, 0, 0); PG8_STAGE(PG8_SA(1, 1), a1 + hstep, voffA);
            PG8_WAIT_V(8); PG8_WAIT_L(0); PG8_BAR; PG8_MMA(0, 0, At, B0); PG8_MMA(0, 1, At, B1); PG8_BAR; PG8_SCHED;
            PG8_LDA(At, 0, 1); PG8_STAGE(PG8_SB(0, 0), b2, voffB); PG8_STAGE(PG8_SB(0, 1), b2 + hstep, voffB); PG8_STAGE(PG8_SA(0, 0), a2, voffA);
            PG8_WAIT_V(8); PG8_WAIT_L(0); PG8_BAR; PG8_MMA(1, 0, At, B0); PG8_MMA(1, 1, At, B1); PG8_BAR; PG8_SCHED;
            PG8_LDB(B0, 1, 0); PG8_LDB(B1, 1, 1); PG8_SCHED; PG8_LDA(At, 1, 0); PG8_STAGE(PG8_SA(0, 1), a2 + hstep, voffA);
            PG8_WAIT_V(8); PG8_WAIT_L(0); PG8_BAR; PG8_MMA(0, 0, At, B0); PG8_MMA(0, 1, At, B1); PG8_BAR; PG8_SCHED;
            PG8_LDA(At, 1, 1); PG8_STAGE(PG8_SB(1, 0), b3, voffB); PG8_STAGE(PG8_SB(1, 1), b3 + hstep, voffB); PG8_STAGE(PG8_SA(1, 0), a3, voffA);
            PG8_WAIT_V(8); PG8_WAIT_L(0); PG8_BAR; PG8_MMA(1, 0, At, B0); PG8_MMA(1, 1, At, B1); PG8_BAR; PG8_SCHED;
            } else {
            PG8_LDB(B0, 0, 0); PG8_SCHED; PG8_LDA(At, 0, 0); PG8_STAGE(PG8_SA(1, 1), a1 + hstep, voffA);
            PG8_WAIT_L(8); PG8_BAR; PG8_WAIT_L(0); PG8_MMA(0, 0, At, B0); PG8_BAR; PG8_SCHED;
            PG8_LDB(B1, 0, 1); PG8_STAGE(PG8_SB(0, 0), b2, voffB);
            PG8_BAR; PG8_WAIT_L(0); PG8_MMA(0, 1, At, B1); PG8_BAR;
            PG8_LDA(At, 0, 1); PG8_STAGE(PG8_SA(0, 0), a2, voffA);
            PG8_BAR; PG8_WAIT_L(0); PG8_MMA(1, 0, At, B0); PG8_BAR; PG8_SCHED;
            PG8_STAGE(PG8_SB(0, 1), b2 + hstep, voffB);
            PG8_WAIT_V(6); PG8_BAR; PG8_MMA(1, 1, At, B1); PG8_BAR;
            PG8_LDB(B0, 1, 0); PG8_SCHED; PG8_LDA(At, 1, 0); PG8_STAGE(PG8_SA(0, 1), a2 + hstep, voffA);
            PG8_WAIT_L(8); PG8_BAR; PG8_WAIT_L(0); PG8_MMA(0, 0, At, B0); PG8_BAR; PG8_SCHED;
            PG8_LDB(B1, 1, 1); PG8_STAGE(PG8_SB(1, 0), b3, voffB);
            PG8_BAR; PG8_WAIT_L(0); PG8_MMA(0, 1, At, B1); PG8_BAR;
            PG8_LDA(At, 1, 1); PG8_STAGE(PG8_SA(1, 0), a3, voffA);
            PG8_BAR; PG8_WAIT_L(0); PG8_MMA(1, 0, At, B0); PG8_BAR; PG8_SCHED;
            PG8_STAGE(PG8_SB(1, 1), b3 + hstep, voffB);
            PG8_WAIT_V(6); PG8_BAR; PG8_MMA(1, 1, At, B1); PG8_BAR;
            }
        }
        if constexpr (ALIGN_EPI) { if (wr == 0) PG8_BAR; }
        if constexpr (!Epi::AFTER_DRAIN) { E(acc, cur, wr, wc, fr, fq); S.done(cur); }
        if (!has_next) break;
#pragma unroll
        for (int a = 0; a < 2; ++a)
#pragma unroll
            for (int b = 0; b < 2; ++b)
#pragma unroll
                for (int m = 0; m < 4; ++m)
#pragma unroll
                    for (int n = 0; n < 2; ++n) acc[a][b][m][n] = (f32x4){0.f, 0.f, 0.f, 0.f};
        cur = nxt; cA = nA; cB = nB; ++ui;
        if constexpr (ALIGN_EPI) { if (wr == 1) PG8_BAR; }
    }
    PG8_WAIT_V(0);
    if constexpr (!ALIGN_EPI) { if (wr == 0) PG8_BAR; }
    PG8_BAR;
    if constexpr (Epi::AFTER_DRAIN) { E.fused(acc, cur, wr, wc, fr, fq, lds, wid, lane); S.done(cur); }
#undef PG8_SA
#undef PG8_SB
#undef PG8_STAGE
#undef PG8_LDA
#undef PG8_LDB
#undef PG8_MMA
#undef PG8_WAIT_V
#undef PG8_WAIT_L
#undef PG8_BAR
#undef PG8_SCHED
}
}
#ifndef MK_ONE_LAUNCH
#define MK_ONE_LAUNCH 1
#endif
constexpr int NWAVES = 8;
constexpr int DM = 1024, INW = 7168, BRW = 2048, MIXW = 1536, XW = 512;
constexpr int TOK = 49152, CH = 16384, NCH = 3;
constexpr int MEMROWS = 1280;
constexpr int NAH = 24, XH = 4;
constexpr int ZQ = 0, ZK = 1536, ZV = 3072, ZQM = 4608, ZG = 5120;
constexpr float RMS_EPS = 1e-6f;
constexpr size_t MiB = 1u << 20;
constexpr size_t WS_CTL = 0, CTL_ZERO_BYTES = 1 * MiB;
constexpr size_t WS_W1T = 2 * MiB;
constexpr size_t WS_W2T = 30 * MiB;
constexpr size_t WS_WKVT = 38 * MiB;
constexpr size_t WS_MEMN = 42 * MiB;
constexpr size_t WS_MKV = 47 * MiB;
constexpr size_t WS_HB = 52 * MiB;
constexpr size_t WS_Y = 148 * MiB;
constexpr size_t WS_Z = 212 * MiB;
constexpr size_t WS_END = 436 * MiB;
constexpr int CW_BAR = 4096;
constexpr int RING_OFF = 0, RING_BYTES = 131072;
constexpr int LDSCTL_OFF = RING_BYTES, MISC_OFF = LDSCTL_OFF + 320;
constexpr int LDS_BYTES = 147456;
constexpr int PH_PREP = 0, PH_MKV = 1, PH_L0 = 2, PH_PER_LAYER = 10, NPHASE = 22;

#define GAS __attribute__((address_space(1)))
#define LAS __attribute__((address_space(3)))
typedef unsigned short bf16;
typedef unsigned v4u __attribute__((ext_vector_type(4)));
typedef float f32x4 __attribute__((ext_vector_type(4)));
typedef GAS unsigned gu32;
#define RLX_AGENT __ATOMIC_RELAXED, __HIP_MEMORY_SCOPE_AGENT
#define LDS_WAIT() asm volatile("s_waitcnt lgkmcnt(0)" ::: "memory")
__device__ __forceinline__ unsigned f2bf(float f) { unsigned u = __builtin_bit_cast(unsigned, f); return (u + 0x7fffu + ((u >> 16) & 1u)) >> 16; }
__device__ __forceinline__ unsigned pk2(float lo, float hi) { return f2bf(lo) | (f2bf(hi) << 16); }
__device__ __forceinline__ float bf2f(unsigned short b) { return __uint_as_float((unsigned)b << 16); }
__device__ __forceinline__ float bflo(unsigned w) { return __uint_as_float(w << 16); }
__device__ __forceinline__ float bfhi(unsigned w) { return __uint_as_float(w & 0xffff0000u); }
__device__ __forceinline__ float silu(float g) { return g / (1.0f + __expf(-g)); }
__device__ __forceinline__ float wave_sum(float v) {
#pragma unroll
    for (int o = 1; o < 64; o <<= 1) v += __shfl_xor(v, o);
    return v;
}
__device__ __forceinline__ float wave_max(float v) {
#pragma unroll
    for (int o = 1; o < 64; o <<= 1) v = fmaxf(v, __shfl_xor(v, o));
    return v;
}
template <int OFF> __device__ __forceinline__ unsigned long long karg64() {
    unsigned long long v; auto ka = __builtin_amdgcn_kernarg_segment_ptr();
    asm volatile("s_load_dwordx2 %0, %1, %2\n\ts_waitcnt lgkmcnt(0)" : "=s"(v) : "s"(ka), "i"(OFF) : "memory");
    return v;
}
#define XB_TMO      128
#define XB_XCNT(j)  (256  + 64 * (j))
#define XB_XSUB(j)  (1280 + 64 * (j))
#define XB_XGEN(j)  (2304 + 64 * (j))
#define XB_TOP      3328
#define XB_TOPGEN   3392
#define XCD_BAR_WORDS 3456
#define XB_SPIN_CAP (1u << 18)

__device__ __forceinline__ unsigned xb_ld(unsigned* p)              { return __hip_atomic_load(p, __ATOMIC_RELAXED, __HIP_MEMORY_SCOPE_AGENT); }
__device__ __forceinline__ unsigned xb_add(unsigned* p, unsigned v) { return __hip_atomic_fetch_add(p, v, __ATOMIC_RELAXED, __HIP_MEMORY_SCOPE_AGENT); }
__device__ __forceinline__ unsigned xb_xcc_id() { return (unsigned)__builtin_amdgcn_s_getreg((3 << 11) | 20) & 0xFu; }
#define XB_SPIN(cond, bar) do { unsigned _sp = 0; while (cond) { __builtin_amdgcn_s_sleep(1); \
    if ((++_sp & 255u) == 0u) { if (xb_ld(&(bar)[XB_TMO])) break; if (_sp > XB_SPIN_CAP) { atomicAdd(&(bar)[XB_TMO], 1u); break; } } } } while (0)

struct XcdBarrier {
    unsigned* bar; unsigned x;
    volatile LAS unsigned* st;
};

__device__ __forceinline__ XcdBarrier xcd_barrier_post(unsigned* bar, volatile LAS unsigned* st) {
    XcdBarrier b; b.bar = bar; b.x = xb_xcc_id(); b.st = st;
    if (threadIdx.x == 0) (void)xb_add(&bar[XB_XCNT(b.x)], 1u);
    return b;
}
__device__ __forceinline__ void xcd_barrier_complete(unsigned* bar, unsigned x, unsigned& nloc, unsigned& nx) {
    const unsigned G = gridDim.x * gridDim.y * gridDim.z;
    unsigned sum, cnt, mine, sp = 0u;
    for (;;) {
        sum = 0u; cnt = 0u; mine = 0u;
#pragma unroll
        for (unsigned j = 0; j < 16; ++j) { const unsigned c = xb_ld(&bar[XB_XCNT(j)]); sum += c; cnt += (c > 0u) ? 1u : 0u; mine = (j == x) ? c : mine; }
        if (sum == G) break;
        __builtin_amdgcn_s_sleep(1);
        if ((++sp & 255u) == 0u) { if (xb_ld(&bar[XB_TMO])) break; if (sp > XB_SPIN_CAP) { atomicAdd(&bar[XB_TMO], 1u); break; } }
    }
    nloc = mine > 0u ? mine : 1u; nx = cnt > 0u ? cnt : 1u;
}

__device__ __forceinline__ void xcd_barrier(const XcdBarrier& b) {
    asm volatile("s_waitcnt vmcnt(0)" ::: "memory");
    __syncthreads();
    if (threadIdx.x == 0) {
        unsigned* bar = b.bar;
        __builtin_amdgcn_s_waitcnt(0);
        unsigned nloc = b.st[0], nx = b.st[1];
        if (nloc == 0u) { xcd_barrier_complete(bar, b.x, nloc, nx); b.st[0] = nloc; b.st[1] = nx; }
        const unsigned old = xb_add(&bar[XB_XSUB(b.x)], 1u);
        const unsigned gen = old / nloc;
        if (old + 1u == (gen + 1u) * nloc) {
            __builtin_amdgcn_fence(__ATOMIC_RELEASE, "agent");
            asm volatile("s_waitcnt vmcnt(0)" ::: "memory");
            const unsigned og = xb_add(&bar[XB_TOP], 1u);
            const unsigned tg = og / nx;
            if (og + 1u == (tg + 1u) * nx) xb_add(&bar[XB_TOPGEN], 1u);
            else XB_SPIN(xb_ld(&bar[XB_TOPGEN]) == tg, bar);
            __builtin_amdgcn_fence(__ATOMIC_ACQUIRE, "agent");
            xb_add(&bar[XB_XGEN(b.x)], 1u);
            asm volatile("s_waitcnt vmcnt(0)" ::: "memory");
        } else {
            XB_SPIN(xb_ld(&bar[XB_XGEN(b.x)]) == gen, bar);
            __builtin_amdgcn_fence(__ATOMIC_ACQUIRE, "agent");
            asm volatile("s_waitcnt vmcnt(0)" ::: "memory");
        }
    }
    __syncthreads();
}
__device__ __forceinline__ void transpose_item(const float* W, int K, int N, bf16* WT, LAS float* scr, int item, int lane) {
    const int nblk = N / 32, kb = item / nblk, nb = item % nblk, k0 = 64 * kb, n0 = 32 * nb;
#pragma unroll 8
    for (int i = 0; i < 32; ++i) { const int kk = 2 * i + (lane >> 5); scr[kk * 33 + (lane & 31)] = W[(size_t)(k0 + kk) * N + n0 + (lane & 31)]; }
    LDS_WAIT(); asm volatile("" ::: "memory");
    const int c = lane & 7;
#pragma unroll
    for (int j = 0; j < 4; ++j) { const int n = (lane >> 3) + 8 * j; const LAS float* s = scr + (8 * c) * 33 + n;
        v4u o; o.x = pk2(s[0 * 33], s[1 * 33]); o.y = pk2(s[2 * 33], s[3 * 33]); o.z = pk2(s[4 * 33], s[5 * 33]); o.w = pk2(s[6 * 33], s[7 * 33]);
        *(GAS v4u*)(WT + (size_t)(n0 + n) * K + k0 + 8 * c) = o; }
    LDS_WAIT(); asm volatile("" ::: "memory");
}
__device__ __forceinline__ void rms_row_to_bf16(const float* xrow, const float* w, bf16* orow, int lane) {
    const GAS f32x4* xr = (const GAS f32x4*)xrow + lane; const GAS f32x4* wr = (const GAS f32x4*)w + lane;
    f32x4 v[4]; float s = 0.f;
#pragma unroll
    for (int j = 0; j < 4; ++j) { v[j] = xr[64 * j]; s += (v[j].x * v[j].x + v[j].y * v[j].y) + (v[j].z * v[j].z + v[j].w * v[j].w); }
    const float rstd = 1.f / sqrtf(wave_sum(s) * (1.f / DM) + RMS_EPS);
    GAS unsigned long long* o8 = (GAS unsigned long long*)orow + lane;
#pragma unroll
    for (int j = 0; j < 4; ++j) { const f32x4 ww = wr[64 * j];
        o8[64 * j] = (unsigned long long)pk2(v[j].x * rstd * ww.x, v[j].y * rstd * ww.y) | ((unsigned long long)pk2(v[j].z * rstd * ww.z, v[j].w * rstd * ww.w) << 32); }
}
__device__ __forceinline__ void rms_row_to_f32(const float* xrow, const float* w, float* orow, int lane) {
    const GAS f32x4* xr = (const GAS f32x4*)xrow + lane; const GAS f32x4* wr = (const GAS f32x4*)w + lane;
    f32x4 v[4]; float s = 0.f;
#pragma unroll
    for (int j = 0; j < 4; ++j) { v[j] = xr[64 * j]; s += (v[j].x * v[j].x + v[j].y * v[j].y) + (v[j].z * v[j].z + v[j].w * v[j].w); }
    const float rstd = 1.f / sqrtf(wave_sum(s) * (1.f / DM) + RMS_EPS);
    GAS f32x4* o = (GAS f32x4*)orow + lane;
#pragma unroll
    for (int j = 0; j < 4; ++j) { const f32x4 ww = wr[64 * j]; o[64 * j] = (v[j] * rstd) * ww; }
}

struct Ptrs {
    const float *xp, *xs, *memp, *mems, *norm_w, *w_in, *w_out, *mem_norm_w, *w_mem_kv, *conv_w, *conv_b, *na_rpb, *final_norm_w;
    float* out;
    bf16 *W1T, *W2T, *WKVT, *MEMN, *MKV, *HB, *Y, *Z;
};

__device__ __forceinline__ void phase_prep(const Ptrs& P, LAS unsigned char* lds, int gw, int NGW, int wave, int lane) {
    LAS float* scr = (LAS float*)(lds + RING_OFF + wave * 16384);
    constexpr int I_W1 = (DM / 64) * (INW / 32), I_W2 = (BRW / 64) * (DM / 32), I_KV = (DM / 64) * (DM / 32);
    constexpr int NITEMS = 2 * (I_W1 + I_W2 + I_KV);
    for (int it = gw; it < NITEMS; it += NGW) {
        int r = it;
        if (r < 2 * I_W1) { const int l = r / I_W1; transpose_item(P.w_in + (size_t)l * DM * INW, DM, INW, P.W1T + (size_t)l * INW * DM, scr, r % I_W1, lane); continue; } r -= 2 * I_W1;
        if (r < 2 * I_W2) { const int l = r / I_W2; transpose_item(P.w_out + (size_t)l * BRW * DM, BRW, DM, P.W2T + (size_t)l * DM * BRW, scr, r % I_W2, lane); continue; } r -= 2 * I_W2;
        { const int l = r / I_KV; transpose_item(P.w_mem_kv + (size_t)l * DM * DM, DM, DM, P.WKVT + (size_t)l * DM * DM, scr, r % I_KV, lane); }
    }
    for (int m = gw; m < 2 * MEMROWS; m += NGW) { const int l = m / MEMROWS, r = m % MEMROWS;
        const float* src = (r < 1024) ? P.memp + (size_t)r * DM : P.mems + (size_t)(r - 1024) * DM;
        rms_row_to_bf16(src, P.mem_norm_w + l * DM, P.MEMN + (size_t)m * DM, lane); }
    for (int m = gw; m < TOK; m += NGW) { const float* src = (m < 32768) ? P.xp + (size_t)m * DM : P.xs + (size_t)(m - 32768) * DM;
        rms_row_to_bf16(src, P.norm_w, P.HB + (size_t)m * DM, lane); }
}

__device__ __forceinline__ void phase_conv(const Ptrs& P, int chunk, int gt, int NGT) {
    const int seqlen = (chunk == 2) ? 16384 : 8192;
    const bf16* z = P.Z; bf16* y = P.Y;
    for (int it = gt; it < CH * (MIXW / 8); it += NGT) {
        const int tl = it / (MIXW / 8), cg = it % (MIXW / 8), ch = cg * 8;
        const int ts = tl % seqlen; const bool hp = ts > 0, hn = ts < seqlen - 1;
        const bf16* zr = z + (size_t)tl * INW + ch;
        const v4u p0 = *(const GAS v4u*)(zr + ZQ), p1 = *(const GAS v4u*)(zr + ZK), p2 = *(const GAS v4u*)(zr + ZV), gg = *(const GAS v4u*)(zr + ZG);
        v4u a1 = (v4u){0, 0, 0, 0}, a2 = a1, b1 = a1, b2 = a1;
        if (hp) { a1 = *(const GAS v4u*)(zr - INW + ZK); a2 = *(const GAS v4u*)(zr - INW + ZV); }
        if (hn) { b1 = *(const GAS v4u*)(zr + INW + ZK); b2 = *(const GAS v4u*)(zr + INW + ZV); }
        float cw0[8], cw1[8], cw2[8], cb[8];
#pragma unroll
        for (int j = 0; j < 8; ++j) { cw0[j] = P.conv_w[ch + j]; cw1[j] = P.conv_w[MIXW + ch + j]; cw2[j] = P.conv_w[2 * MIXW + ch + j]; cb[j] = P.conv_b[ch + j]; }
        v4u o;
#pragma unroll
        for (int w = 0; w < 4; ++w) {
            float r[2];
#pragma unroll
            for (int e = 0; e < 2; ++e) {
                const int j = 2 * w + e;
                const float vp = e ? bfhi(a1[w]) * bfhi(a2[w]) : bflo(a1[w]) * bflo(a2[w]);
                const float vc = e ? bfhi(p1[w]) * bfhi(p2[w]) : bflo(p1[w]) * bflo(p2[w]);
                const float vn = e ? bfhi(b1[w]) * bfhi(b2[w]) : bflo(b1[w]) * bflo(b2[w]);
                const float conv = vp * cw0[j] + vc * cw1[j] + vn * cw2[j] + cb[j];
                const float b = e ? bfhi(p0[w]) : bflo(p0[w]);
                const float g = e ? bfhi(gg[w]) : bflo(gg[w]);
                r[e] = b * conv * silu(g);
            }
            o[w] = pk2(r[0], r[1]);
        }
        *(GAS v4u*)(y + (size_t)tl * BRW + ch) = o;
    }
}

__device__ __forceinline__ void phase_na_naive(const Ptrs& P, int chunk, int gw, int NGW, int lane) {
    const int seqlen = (chunk == 2) ? 16384 : 8192; const int rows = seqlen / 64;
    const bf16* z = P.Z; bf16* y = P.Y; const float* rpb = P.na_rpb;
    for (int task = gw; task < CH * NAH; task += NGW) {
        const int tl = task / NAH, h = task % NAH;
        const int ss = (tl / seqlen) * seqlen, ts = tl - ss, r = ts >> 6, c = ts & 63;
        int r0 = r - 4; r0 = r0 < 0 ? 0 : (r0 > rows - 8 ? rows - 8 : r0);
        int c0 = c - 8; c0 = c0 < 0 ? 0 : (c0 > 48 ? 48 : c0);
        v4u qv[8];
        { const GAS v4u* qp = (const GAS v4u*)(z + (size_t)tl * INW + ZQ + h * 64);
#pragma unroll
          for (int i = 0; i < 8; ++i) qv[i] = qp[i]; }
        float lg[2];
#pragma unroll
        for (int u = 0; u < 2; ++u) {
            const int kk = lane + 64 * u, a = kk >> 4, j = kk & 15;
            const int kt = ss + (r0 + a) * 64 + c0 + j;
            const GAS v4u* kp = (const GAS v4u*)(z + (size_t)kt * INW + ZK + h * 64);
            float dot = 0.f;
#pragma unroll
            for (int i = 0; i < 8; ++i) { const v4u kv = kp[i];
#pragma unroll
                for (int w = 0; w < 4; ++w) dot += bflo(qv[i][w]) * bflo(kv[w]) + bfhi(qv[i][w]) * bfhi(kv[w]); }
            lg[u] = dot * 0.125f + rpb[(h * 15 + (r0 + a - r + 7)) * 31 + (c0 + j - c + 15)];
        }
        const float mx = wave_max(fmaxf(lg[0], lg[1]));
        float pe[2]; pe[0] = __expf(lg[0] - mx); pe[1] = __expf(lg[1] - mx);
        const float inv = 1.f / wave_sum(pe[0] + pe[1]);
        pe[0] *= inv; pe[1] *= inv;
        float o = 0.f;
#pragma unroll
        for (int u = 0; u < 2; ++u)
            for (int kl = 0; kl < 64; ++kl) {
                const float p = __shfl(pe[u], kl);
                const int kk = kl + 64 * u, a = kk >> 4, j = kk & 15;
                const int kt = ss + (r0 + a) * 64 + c0 + j;
                o += p * bf2f(z[(size_t)kt * INW + ZV + h * 64 + lane]);
            }
        const float g = bf2f(z[(size_t)tl * INW + ZG + h * 64 + lane]);
        y[(size_t)tl * BRW + h * 64 + lane] = (bf16)f2bf(o * silu(g));
    }
}

__device__ __forceinline__ void phase_xattn_naive(const Ptrs& P, int layer, int chunk, int gw, int NGW, int lane) {
    const bf16* z = P.Z; bf16* y = P.Y;
    for (int task = gw; task < CH * XH; task += NGW) {
        const int tl = task / XH, h = task % XH;
        const int g = chunk * CH + tl, s = (g < 32768) ? (g >> 13) : 4;
        const bf16* kb = P.MKV + ((size_t)layer * MEMROWS + s * 256) * DM + h * 128;
        const bf16* vb = kb + 512;
        v4u qv[16];
        { const GAS v4u* qp = (const GAS v4u*)(z + (size_t)tl * INW + ZQM + h * 128);
#pragma unroll
          for (int i = 0; i < 16; ++i) qv[i] = qp[i]; }
        float lg[4];
#pragma unroll
        for (int u = 0; u < 4; ++u) {
            const int key = lane + 64 * u;
            const GAS v4u* kp = (const GAS v4u*)(kb + (size_t)key * DM);
            float dot = 0.f;
#pragma unroll
            for (int i = 0; i < 16; ++i) { const v4u kv = kp[i];
#pragma unroll
                for (int w = 0; w < 4; ++w) dot += bflo(qv[i][w]) * bflo(kv[w]) + bfhi(qv[i][w]) * bfhi(kv[w]); }
            lg[u] = dot * 0.08838834764831845f;
        }
        const float mx = wave_max(fmaxf(fmaxf(lg[0], lg[1]), fmaxf(lg[2], lg[3])));
        float pe[4]; float sm = 0.f;
#pragma unroll
        for (int u = 0; u < 4; ++u) { pe[u] = __expf(lg[u] - mx); sm += pe[u]; }
        const float inv = 1.f / wave_sum(sm);
        float o0 = 0.f, o1 = 0.f;
#pragma unroll
        for (int u = 0; u < 4; ++u)
            for (int kl = 0; kl < 64; ++kl) {
                const float p = __shfl(pe[u], kl) * inv;
                const unsigned vv = *(const GAS unsigned*)(vb + (size_t)(kl + 64 * u) * DM + 2 * lane);
                o0 += p * bflo(vv); o1 += p * bfhi(vv);
            }
        const unsigned gg = *(const GAS unsigned*)(z + (size_t)tl * INW + ZG + MIXW + h * 128 + 2 * lane);
        *(GAS unsigned*)(y + (size_t)tl * BRW + MIXW + h * 128 + 2 * lane) = pk2(o0 * silu(bflo(gg)), o1 * silu(bfhi(gg)));
    }
}
struct Args { const float* in[13]; float* out; unsigned char* ws; int ph_lo, ph_hi; };
__global__ void __launch_bounds__(NWAVES * 64, 2) fwd_kernel(Args args) {
    extern __shared__ __attribute__((aligned(16))) unsigned char lds_raw[];
    LAS unsigned char* lds = (LAS unsigned char*)lds_raw;
    volatile LAS unsigned* MISC = (volatile LAS unsigned*)(lds + MISC_OFF);
#define KARG(off) karg64<(off)>()
#define LOAD_PTRS() Ptrs P; do { unsigned char* ws_ = (unsigned char*)(GAS unsigned char*)KARG(112); \
    P.xp = (const float*)(const GAS float*)KARG(0); P.xs = (const float*)(const GAS float*)KARG(8); P.memp = (const float*)(const GAS float*)KARG(16); P.mems = (const float*)(const GAS float*)KARG(24); P.norm_w = (const float*)(const GAS float*)KARG(32); \
    P.w_in = (const float*)(const GAS float*)KARG(40); P.w_out = (const float*)(const GAS float*)KARG(48); P.mem_norm_w = (const float*)(const GAS float*)KARG(56); P.w_mem_kv = (const float*)(const GAS float*)KARG(64); P.conv_w = (const float*)(const GAS float*)KARG(72); \
    P.conv_b = (const float*)(const GAS float*)KARG(80); P.na_rpb = (const float*)(const GAS float*)KARG(88); P.final_norm_w = (const float*)(const GAS float*)KARG(96); P.out = (float*)(GAS float*)KARG(104); \
    P.W1T = (bf16*)(ws_ + WS_W1T); P.W2T = (bf16*)(ws_ + WS_W2T); P.WKVT = (bf16*)(ws_ + WS_WKVT); P.MEMN = (bf16*)(ws_ + WS_MEMN); P.MKV = (bf16*)(ws_ + WS_MKV); \
    P.HB = (bf16*)(ws_ + WS_HB); P.Y = (bf16*)(ws_ + WS_Y); P.Z = (bf16*)(ws_ + WS_Z); } while (0)
    for (int u = threadIdx.x; u < (LDS_BYTES - LDSCTL_OFF) / 4; u += NWAVES * 64) ((LAS unsigned*)(lds + LDSCTL_OFF))[u] = 0u;
    __syncthreads();
    const int lo = args.ph_lo, hi = args.ph_hi;
    if (hi - lo > 1) (void)xcd_barrier_post((unsigned*)((gu32*)((GAS unsigned char*)KARG(112) + WS_CTL) + CW_BAR), MISC + 8);

    for (int ph = lo; ph < hi; ++ph) {
        int tid = threadIdx.x; asm volatile("" : "+v"(tid));
        int bx = blockIdx.x; asm volatile("" : "+s"(bx));
        int G = gridDim.x; asm volatile("" : "+s"(G));
        const int lane = tid & 63, wave = __builtin_amdgcn_readfirstlane(tid >> 6);
        const int vcu = (G % 8 == 0) ? (bx % 8) * (G / 8) + bx / 8 : bx;
        const int gw = vcu * NWAVES + wave, NGW = G * NWAVES;
        const int gt = vcu * (NWAVES * 64) + tid, NGT = G * NWAVES * 64;
        LOAD_PTRS();
        if (ph == PH_PREP) {
            phase_prep(P, lds, gw, NGW, wave, lane);
        } else if (ph == PH_MKV) {
            for (int l = 0; l < 2; ++l) {
                pg8::Gemm g{P.MEMN + (size_t)l * MEMROWS * DM, P.WKVT + (size_t)l * DM * DM, MEMROWS, DM, DM};
                pg8::StaticOrder S; S.init(MEMROWS, DM, G, (bx + 128 * l) % G);
                pg8::EpiBf16<0> E{P.MKV + (size_t)l * MEMROWS * DM, DM, nullptr, 0, 0, 1.f};
                pg8::gemm_phase<pg8::EpiBf16<0>, pg8::StaticOrder, true, true>(lds + RING_OFF, g, S, E, tid);
            }
        } else {
            const int q = ph - PH_L0, layer = q / PH_PER_LAYER, r = q % PH_PER_LAYER;
            if (r == 9) {
                if (layer == 0) { for (int m = gw; m < TOK; m += NGW) rms_row_to_bf16(P.out + (size_t)m * DM, P.norm_w + DM, P.HB + (size_t)m * DM, lane); }
                else { for (int m = gw; m < TOK; m += NGW) rms_row_to_f32(P.out + (size_t)m * DM, P.final_norm_w, P.out + (size_t)m * DM, lane); }
            } else {
                const int chunk = r / 3, kind = r % 3;
                if (kind == 0) {
                    pg8::Gemm g{P.HB + (size_t)chunk * CH * DM, P.W1T + (size_t)layer * INW * DM, CH, INW, DM};
                    pg8::StaticOrder S; S.init(CH, INW, G, bx);
                    pg8::EpiBf16<0> E{P.Z, INW, nullptr, 0, 0, 1.f};
                    pg8::gemm_phase<pg8::EpiBf16<0>, pg8::StaticOrder, true, true>(lds + RING_OFF, g, S, E, tid);
                } else if (kind == 1) {
                    if (layer == 0) phase_conv(P, chunk, gt, NGT); else phase_na_naive(P, chunk, gw, NGW, lane);
                    phase_xattn_naive(P, layer, chunk, gw, NGW, lane);
                } else {
                    const float* base = (layer == 0) ? ((chunk < 2) ? P.xp + (size_t)chunk * CH * DM : P.xs) : P.out + (size_t)chunk * CH * DM;
                    pg8::Gemm g{P.Y, P.W2T + (size_t)layer * DM * BRW, CH, DM, BRW};
                    pg8::StaticOrder S; S.init(CH, DM, G, bx);
                    pg8::EpiResF32 E{base, P.out + (size_t)chunk * CH * DM, DM};
                    pg8::gemm_phase<pg8::EpiResF32, pg8::StaticOrder, true, true>(lds + RING_OFF, g, S, E, tid);
                }
            }
        }
        if (ph + 1 < hi) { XcdBarrier bar; bar.bar = (unsigned*)((gu32*)((GAS unsigned char*)KARG(112) + WS_CTL) + CW_BAR); bar.x = xb_xcc_id(); bar.st = MISC + 8; xcd_barrier(bar); }
    }
}

extern "C" void kernel_launch(void* const* d_in, const int* in_sizes, int n_in, void* d_out, int out_size, void* d_ws, size_t ws_size, hipStream_t stream) {
    static int grid = 0;
    if (grid == 0) {
        if (n_in != 13 || out_size != TOK * DM || ws_size < WS_END) { fprintf(stderr, "kernel_launch: unexpected shapes (n_in %d out %d ws %zu)\n", n_in, out_size, ws_size); grid = -1; return; }
        int dev = 0, cus = 0, per_cu = 0;
        if (hipGetDevice(&dev) != hipSuccess || hipDeviceGetAttribute(&cus, hipDeviceAttributeMultiprocessorCount, dev) != hipSuccess) { grid = -1; return; }
        if (hipFuncSetAttribute((const void*)fwd_kernel, hipFuncAttributeMaxDynamicSharedMemorySize, LDS_BYTES) != hipSuccess) { fprintf(stderr, "kernel_launch: hipFuncSetAttribute failed\n"); grid = -1; return; }
        if (hipOccupancyMaxActiveBlocksPerMultiprocessor(&per_cu, (const void*)fwd_kernel, NWAVES * 64, LDS_BYTES) != hipSuccess || per_cu < 1) { fprintf(stderr, "kernel_launch: occupancy query says %d\n", per_cu); per_cu = 1; }
        (void)hipGetLastError();
        grid = cus;
    }
    if (grid < 0) return;
    (void)hipMemsetAsync((char*)d_ws + WS_CTL, 0, CTL_ZERO_BYTES, stream);
    Args a{};
    for (int i = 0; i < 13; ++i) a.in[i] = (const float*)d_in[i];
    a.out = (float*)d_out; a.ws = (unsigned char*)d_ws;
#if MK_ONE_LAUNCH
    a.ph_lo = 0; a.ph_hi = NPHASE;
    hipLaunchKernelGGL(fwd_kernel, dim3(grid), dim3(NWAVES * 64), LDS_BYTES, stream, a);
#else
    for (int ph = 0; ph < NPHASE; ++ph) { a.ph_lo = ph; a.ph_hi = ph + 1;
        hipLaunchKernelGGL(fwd_kernel, dim3(grid), dim3(NWAVES * 64), LDS_BYTES, stream, a); }
#endif
}
```

```cpp
#include <hip/hip_runtime.h>
#include <cstdio>
#include <cstdint>
namespace pg8 {
#define PG8_LAS __attribute__((address_space(3)))
typedef unsigned short bf16_t;
typedef short bf16x8 __attribute__((ext_vector_type(8)));
typedef float f32x4 __attribute__((ext_vector_type(4)));
typedef unsigned u32x4 __attribute__((ext_vector_type(4)));
constexpr int BM = 256, BK = 64, HALF = 128, HTB = HALF * BK * 2  , STAGE_BYTES = 8 * HTB, NXCD = 8, WGM = 8;

__host__ __device__ __forceinline__ int lds_byte(int r, int c) { const int st = (r >> 4) * 2 + (c >> 5), rr = r & 15, cc = c & 31, ob = rr * 64 + cc * 2; return st * 1024 + (ob ^ (((ob >> 9) & 1) << 5)); }
__host__ __device__ __forceinline__ void stage_rc(int b, int& R, int& C) { const int st = b / 1024, sb = b % 1024, swz = sb ^ (((sb >> 9) & 1) << 5); R = (st >> 1) * 16 + swz / 64; C = (st & 1) * 32 + (swz % 64) / 2; }
__host__ __device__ __forceinline__ int perm32(int rho) { const int n = rho >> 4, i = rho & 15; return 8 * (i >> 2) + 4 * n + (i & 3); }

struct Unit { int pm, pn; };
struct Gemm { const bf16_t* A; const bf16_t* Bt; int M, N, K; };

struct StaticOrder {
    int nM, nN, nwg, G, c;
    __host__ __device__ void init(int M, int N, int G_, int c_) { nM = M / BM; nN = N / BM; nwg = nM * nN; G = G_; c = c_; }
    __host__ __device__ bool next(int i, Unit& u) const {
        const long L = (long)i * G + c; if (L >= nwg) return false;
        int wgid = (int)L; { const int q = nwg / NXCD, r = nwg % NXCD, xcd = wgid % NXCD, off = wgid / NXCD; wgid = (xcd < r ? xcd * (q + 1) : r * (q + 1) + (xcd - r) * q) + off; }
        const int nig = WGM * nN, gid = wgid / nig, fm = gid * WGM, gsz = (nM - fm) < WGM ? (nM - fm) : WGM;
        u.pm = fm + ((wgid % nig) % gsz); u.pn = (wgid % nig) / gsz; return true;
    }
    __device__ __forceinline__ void a_ready(const Unit&) const {}
    __device__ __forceinline__ void done(const Unit&) const {}
};

__device__ __forceinline__ unsigned cvt_pk_bf16(float lo, float hi) { unsigned r; asm volatile("v_cvt_pk_bf16_f32 %0, %1, %2" : "=v"(r) : "v"(lo), "v"(hi)); return r; }
typedef float f32x2 __attribute__((ext_vector_type(2)));
__device__ __forceinline__ f32x2 gelu_pk(f32x2 v) {
    const f32x2 av = __builtin_elementwise_abs(v), d = av * 0.2316418882f + 1.0f;
    f32x2 t; t.x = __builtin_amdgcn_rcpf(d.x); t.y = __builtin_amdgcn_rcpf(d.y);
    f32x2 q = t * 0.5307027145f + (-0.7265760135f); q = q * t + 0.7107068705f; q = q * t + (-0.142248368f); q = q * t + 0.127414796f; q = q * t;
    const f32x2 s = (v * v) * (-0.72134752044f);
    f32x2 e; e.x = __builtin_amdgcn_exp2f(s.x); e.y = __builtin_amdgcn_exp2f(s.y);
    const f32x2 m = v * (q * e), r = v - m;
    f32x2 o; o.x = v.x < 0.f ? m.x : r.x; o.y = v.y < 0.f ? m.y : r.y; return o;
}

template <int ACT  > struct EpiBf16 {
    static constexpr bool PERM = true, AFTER_DRAIN = false; static_assert(ACT == 0 || ACT == 1, "EpiBf16: ACT is 0 (none) or 1 (gelu_pk)");
    bf16_t* O; int ldc; const float* bias; int split_cols; size_t split_stride; float scale0;
    __device__ __forceinline__ void operator()(const f32x4 (&acc)[2][2][4][2], const Unit& u, int wr, int wc, int fr, int fq) const {
        const int row0 = u.pm * BM + wr * 64 + fr; int colt = u.pn * BM; bf16_t* base = O;
        float sc = 1.f; if (split_cols) { const int t = colt / split_cols; base += (size_t)t * split_stride; colt -= t * split_cols; if (t == 0) sc = scale0; }
        const int col0 = colt + wc * 32 + 8 * fq, bcol0 = u.pn * BM + wc * 32 + 8 * fq;
        f32x4 bv[2][2];
#pragma unroll
        for (int bj = 0; bj < 2; ++bj)
#pragma unroll
            for (int n = 0; n < 2; ++n) bv[bj][n] = bias ? *(const f32x4*)(bias + bcol0 + bj * HALF + 4 * n) : (f32x4){0.f, 0.f, 0.f, 0.f};
#pragma unroll
        for (int ai = 0; ai < 2; ++ai)
#pragma unroll
            for (int m = 0; m < 4; ++m) { bf16_t* rowp = base + (size_t)(row0 + ai * HALF + m * 16) * ldc + col0;
#pragma unroll
                for (int bj = 0; bj < 2; ++bj) { f32x4 v0 = acc[ai][bj][m][0] + bv[bj][0], v1 = acc[ai][bj][m][1] + bv[bj][1];
                    if (ACT == 1) { f32x2 a = gelu_pk((f32x2){v0[0], v0[1]}), b = gelu_pk((f32x2){v0[2], v0[3]}), c = gelu_pk((f32x2){v1[0], v1[1]}), d = gelu_pk((f32x2){v1[2], v1[3]});
                        v0 = (f32x4){a.x, a.y, b.x, b.y}; v1 = (f32x4){c.x, c.y, d.x, d.y}; }
                    v0 = v0 * sc; v1 = v1 * sc; u32x4 w; w.x = cvt_pk_bf16(v0[0], v0[1]); w.y = cvt_pk_bf16(v0[2], v0[3]); w.z = cvt_pk_bf16(v1[0], v1[1]); w.w = cvt_pk_bf16(v1[2], v1[3]);
                    *(u32x4*)(rowp + bj * HALF) = w; } }
    }
};
struct EpiResF32 {
    static constexpr bool PERM = false, AFTER_DRAIN = false;
    const float* base; float* out; int ldc;
    __device__ __forceinline__ void operator()(const f32x4 (&acc)[2][2][4][2], const Unit& u, int wr, int wc, int fr, int fq) const {
        const int row0 = u.pm * BM + wr * 64 + fr, col0 = u.pn * BM + wc * 32 + 4 * fq;
#pragma unroll
        for (int ai = 0; ai < 2; ++ai)
#pragma unroll
            for (int m = 0; m < 4; ++m) { const size_t off = (size_t)(row0 + ai * HALF + m * 16) * ldc + col0;
#pragma unroll
                for (int bj = 0; bj < 2; ++bj)
#pragma unroll
                    for (int n = 0; n < 2; ++n) { const f32x4 bs = *(const f32x4*)(base + off + bj * HALF + n * 16); *(f32x4*)(out + off + bj * HALF + n * 16) = bs + acc[ai][bj][m][n]; }
                if (m & 1) asm volatile("" ::: "memory"); }
    }
};
template <class Epi, class Sched, bool ALIGN_EPI = false, bool SP2 = false>
__device__ __forceinline__ void gemm_phase(PG8_LAS unsigned char* lds, const Gemm g, const Sched& S, const Epi& E, const int tid) {
    const int wid = __builtin_amdgcn_readfirstlane(tid >> 6), lane = tid & 63, wr = wid >> 2, wc = wid & 3, fr = lane & 15, fq = lane >> 4;
    const int K = g.K, nt = K / BK;
    unsigned voffA[2], voffB[2];
#pragma unroll
    for (int i = 0; i < 2; ++i) { int R, C; stage_rc(tid * 16 + i * 8192, R, C); const int Rb = Epi::PERM ? ((R & ~31) + perm32(R & 31)) : R;
        voffA[i] = (unsigned)(R * K + C) * 2u; voffB[i] = (unsigned)(Rb * K + C) * 2u; }
    const size_t kstep = (size_t)(BK * 2);
    const size_t hstep = (size_t)HALF * K * 2;
    const size_t tstep = 2 * hstep;
    const unsigned ldsw = (unsigned)wid * 1024u;
    const int aoff = lds_byte(wr * 64 + fr, fq * 8), boff = lds_byte(wc * 32 + fr, fq * 8);
#define PG8_SA(b, h) (((b) * 2 + (h)) * HTB)
#define PG8_SB(b, h) ((4 + (b) * 2 + (h)) * HTB)
#define PG8_STAGE(bufoff, gbase, voff) do { _Pragma("unroll") for (int _i = 0; _i < 2; ++_i) \
        __builtin_amdgcn_global_load_lds((const unsigned*)((const char*)(gbase) + (voff)[_i]), (PG8_LAS unsigned*)(lds + (bufoff) + ldsw + _i * 8192), 16, 0, 0); } while (0)
#define PG8_LDA(dst, b, h) do { _Pragma("unroll") for (int m = 0; m < 4; ++m) _Pragma("unroll") for (int k = 0; k < 2; ++k) dst[m][k] = *(const PG8_LAS bf16x8*)(lds + PG8_SA(b, h) + aoff + m * 2048 + k * 1024); } while (0)
#define PG8_LDB(dst, b, h) do { _Pragma("unroll") for (int n = 0; n < 2; ++n) _Pragma("unroll") for (int k = 0; k < 2; ++k) dst[n][k] = *(const PG8_LAS bf16x8*)(lds + PG8_SB(b, h) + boff + n * 2048 + k * 1024); } while (0)
#define PG8_MMA(ai, bj, At, Bt) do { __builtin_amdgcn_s_setprio(1); _Pragma("unroll") for (int m = 0; m < 4; ++m) _Pragma("unroll") for (int n = 0; n < 2; ++n) _Pragma("unroll") for (int k = 0; k < 2; ++k) \
        acc[ai][bj][m][n] = __builtin_amdgcn_mfma_f32_16x16x32_bf16(Bt[n][k], At[m][k], acc[ai][bj][m][n], 0, 0, 0); __builtin_amdgcn_s_setprio(0); } while (0)
#define PG8_WAIT_V(n) asm volatile("s_waitcnt vmcnt(" #n ")" ::: "memory")
#define PG8_WAIT_L(n) asm volatile("s_waitcnt lgkmcnt(" #n ")" ::: "memory")
#define PG8_BAR __builtin_amdgcn_s_barrier()
#define PG8_SCHED __builtin_amdgcn_sched_barrier(0)
    Unit cur, nxt; int ui = 0;
    if (!S.next(0, cur)) return;
    f32x4 acc[2][2][4][2];
#pragma unroll
    for (int a = 0; a < 2; ++a)
#pragma unroll
        for (int b = 0; b < 2; ++b)
#pragma unroll
            for (int m = 0; m < 4; ++m)
#pragma unroll
                for (int n = 0; n < 2; ++n) acc[a][b][m][n] = (f32x4){0.f, 0.f, 0.f, 0.f};
    bf16x8 At[4][2], B0[2][2], B1[2][2];
    const char* cA = (const char*)g.A + (size_t)cur.pm * tstep; const char* cB = (const char*)g.Bt + (size_t)cur.pn * tstep;
    S.a_ready(cur);
    if constexpr (SP2) {
        PG8_STAGE(PG8_SB(0, 0), cB, voffB); PG8_STAGE(PG8_SB(0, 1), cB + hstep, voffB); PG8_STAGE(PG8_SA(0, 0), cA, voffA); PG8_STAGE(PG8_SA(0, 1), cA + hstep, voffA);
        if (wr == 1) PG8_BAR;
        PG8_WAIT_V(2); PG8_BAR;
        PG8_STAGE(PG8_SB(1, 0), cB + kstep, voffB); PG8_STAGE(PG8_SA(1, 0), cA + kstep, voffA); PG8_STAGE(PG8_SB(1, 1), cB + hstep + kstep, voffB);
        PG8_WAIT_V(6); PG8_BAR;
    } else {
        PG8_STAGE(PG8_SB(0, 0), cB, voffB); PG8_STAGE(PG8_SA(0, 0), cA, voffA); PG8_STAGE(PG8_SB(0, 1), cB + hstep, voffB); PG8_STAGE(PG8_SA(0, 1), cA + hstep, voffA);
        if (wr == 1) PG8_BAR;
        PG8_WAIT_V(4); PG8_BAR;
        PG8_STAGE(PG8_SB(1, 0), cB + kstep, voffB); PG8_STAGE(PG8_SA(1, 0), cA + kstep, voffA); PG8_STAGE(PG8_SB(1, 1), cB + hstep + kstep, voffB);
        PG8_WAIT_V(6); PG8_BAR;
    }
    for (;;) {
        const bool has_next = S.next(ui + 1, nxt);
        const char* nA = has_next ? (const char*)g.A + (size_t)nxt.pm * tstep : cA; const char* nB = has_next ? (const char*)g.Bt + (size_t)nxt.pn * tstep : cB;
        for (int t = 0; t < nt; t += 2) {
            const bool last = (t == nt - 2);
            const char* a1 = cA + (size_t)(t + 1) * kstep;
            const char* a2 = last ? nA : cA + (size_t)(t + 2) * kstep; const char* b2 = last ? nB : cB + (size_t)(t + 2) * kstep;
            const char* a3 = a2 + kstep; const char* b3 = b2 + kstep;
            if (last && has_next) S.a_ready(nxt);
            if constexpr (SP2) {
            PG8_LDB(B0, 0, 0); PG8_LDB(B1, 0, 1); PG8_SCHED; PG8_LDA(At, 0, 0); PG8_STAGE(PG8_SA(1, 1), a1 + hstep, voffA);
            PG8_WAIT_V(8); PG8_WAIT_L(0); PG8_BAR; PG8_MMA(0, 0, At, B0); PG8_MMA(0, 1, At, B1); PG8_BAR; PG8_SCHED;
            PG8_LDA(At, 0, 1); PG8_STAGE(PG8_SB(0, 0), b2, voffB); PG8_STAGE(PG8_SB(0, 1), b2 + hstep, voffB); PG8_STAGE(PG8_SA(0, 0), a2, voffA);
            PG8_WAIT_V(8); PG8_WAIT_L(0); PG8_BAR; PG8_MMA(1, 0, At, B0); PG8_MMA(1, 1, At, B1); PG8_BAR; PG8_SCHED;
            PG8_LDB(B0, 1, 0); PG8_LDB(B1, 1, 1); PG8_SCHED; PG8_LDA(At, 1, 0); PG8_STAGE(PG8_SA(0, 1), a2 + hstep, voffA);
            PG8_WAIT_V(8); PG8_WAIT_L(0); PG8_BAR; PG8_MMA(0, 0, At, B0); PG8_MMA(0, 1, At, B1); PG8_BAR; PG8_SCHED;
            PG8_LDA(At, 1, 1); PG8_STAGE(PG8_SB(1, 0), b3, voffB); PG8_STAGE(PG8_SB(1, 1), b3 + hstep, voffB); PG8_STAGE(PG8_SA(1, 0), a3, voffA);
            PG8_WAIT_V(8); PG8_WAIT_L(0); PG8_BAR; PG8_MMA(1, 0, At, B0); PG8_MMA(1, 1, At, B1); PG8_BAR; PG8_SCHED;
            } else {
            PG8_LDB(B0, 0, 0); PG8_SCHED; PG8_LDA(At, 0, 0); PG8_STAGE(PG8_SA(1, 1), a1 + hstep, voffA);
            PG8_WAIT_L(8); PG8_BAR; PG8_WAIT_L(0); PG8_MMA(0, 0, At, B0); PG8_BAR; PG8_SCHED;
            PG8_LDB(B1, 0, 1); PG8_STAGE(PG8_SB(0, 0), b2, voffB);
            PG8_BAR; PG8_WAIT_L(0); PG8_MMA(0, 1, At, B1); PG8_BAR;
            PG8_LDA(At, 0, 1); PG8_STAGE(PG8_SA(0, 0), a2, voffA);
            PG8_BAR; PG8_WAIT_L(0); PG8_MMA(1, 0, At, B0); PG8_BAR; PG8_SCHED;
            PG8_STAGE(PG8_SB(0, 1), b2 + hstep, voffB);
            PG8_WAIT_V(6); PG8_BAR; PG8_MMA(1, 1, At, B1); PG8_BAR;
            PG8_LDB(B0, 1, 0); PG8_SCHED; PG8_LDA(At, 1, 0); PG8_STAGE(PG8_SA(0, 1), a2 + hstep, voffA);
            PG8_WAIT_L(8); PG8_BAR; PG8_WAIT_L(0); PG8_MMA(0, 0, At, B0); PG8_BAR; PG8_SCHED;
            PG8_LDB(B1, 1, 1); PG8_STAGE(PG8_SB(1, 0), b3, voffB);
            PG8_BAR; PG8_WAIT_L(0); PG8_MMA(0, 1, At, B1); PG8_BAR;
            PG8_LDA(At, 1, 1); PG8_STAGE(PG8_SA(1, 0), a3, voffA);
            PG8_BAR; PG8_WAIT_L(0); PG8_MMA(1, 0, At, B0); PG8_BAR; PG8_SCHED;
            PG8_STAGE(PG8_SB(1, 1), b3 + hstep, voffB);
            PG8_WAIT_V(6); PG8_BAR; PG8_MMA(1, 1, At, B1); PG8_BAR;
            }
        }
        if constexpr (ALIGN_EPI) { if (wr == 0) PG8_BAR; }
        if constexpr (!Epi::AFTER_DRAIN) { E(acc, cur, wr, wc, fr, fq); S.done(cur); }
        if (!has_next) break;
#pragma unroll
        for (int a = 0; a < 2; ++a)
#pragma unroll
            for (int b = 0; b < 2; ++b)
#pragma unroll
                for (int m = 0; m < 4; ++m)
#pragma unroll
                    for (int n = 0; n < 2; ++n) acc[a][b][m][n] = (f32x4){0.f, 0.f, 0.f, 0.f};
        cur = nxt; cA = nA; cB = nB; ++ui;
        if constexpr (ALIGN_EPI) { if (wr == 1) PG8_BAR; }
    }
    PG8_WAIT_V(0);
    if constexpr (!ALIGN_EPI) { if (wr == 0) PG8_BAR; }
    PG8_BAR;
    if constexpr (Epi::AFTER_DRAIN) { E.fused(acc, cur, wr, wc, fr, fq, lds, wid, lane); S.done(cur); }
#undef PG8_SA
#undef PG8_SB
#undef PG8_STAGE
#undef PG8_LDA
#undef PG8_LDB
#undef PG8_MMA
#undef PG8_WAIT_V
#undef PG8_WAIT_L
#undef PG8_BAR
#undef PG8_SCHED
}
}
#ifndef MK_ONE_LAUNCH
#define MK_ONE_LAUNCH 1
#endif
constexpr int NWAVES = 8;
constexpr int DM = 1024, INW = 7168, BRW = 2048, MIXW = 1536, XW = 512;
constexpr int TOK = 49152, CH = 16384, NCH = 3;
constexpr int MEMROWS = 1280;
constexpr int NAH = 24, XH = 4;
constexpr int ZQ = 0, ZK = 1536, ZV = 3072, ZQM = 4608, ZG = 5120;
constexpr float RMS_EPS = 1e-6f;
constexpr size_t MiB = 1u << 20;
constexpr size_t WS_CTL = 0, CTL_ZERO_BYTES = 1 * MiB;
constexpr size_t WS_W1T = 2 * MiB;
constexpr size_t WS_W2T = 30 * MiB;
constexpr size_t WS_WKVT = 38 * MiB;
constexpr size_t WS_MEMN = 42 * MiB;
constexpr size_t WS_MKV = 47 * MiB;
constexpr size_t WS_HB = 52 * MiB;
constexpr size_t WS_Y = 148 * MiB;
constexpr size_t WS_Z = 212 * MiB;
constexpr size_t WS_KIMG = 436 * MiB;
constexpr size_t WS_VTIMG = 439 * MiB;
constexpr size_t WS_END = 442 * MiB;
constexpr int CW_BAR = 4096;
constexpr int RING_OFF = 0, RING_BYTES = 131072;
constexpr int LDSCTL_OFF = RING_BYTES, MISC_OFF = LDSCTL_OFF + 320;
constexpr int LDS_BYTES = 147456;
constexpr int PH_PREP = 0, PH_MKV = 1, PH_IMG = 2, PH_L0 = 3, PH_PER_LAYER = 10, NPHASE = 23;

#define GAS __attribute__((address_space(1)))
#define LAS __attribute__((address_space(3)))
typedef unsigned short bf16;
typedef unsigned v4u __attribute__((ext_vector_type(4)));
typedef float f32x4 __attribute__((ext_vector_type(4)));
typedef GAS unsigned gu32;
#define RLX_AGENT __ATOMIC_RELAXED, __HIP_MEMORY_SCOPE_AGENT
#define LDS_WAIT() asm volatile("s_waitcnt lgkmcnt(0)" ::: "memory")
__device__ __forceinline__ unsigned f2bf(float f) { unsigned u = __builtin_bit_cast(unsigned, f); return (u + 0x7fffu + ((u >> 16) & 1u)) >> 16; }
__device__ __forceinline__ unsigned pk2(float lo, float hi) { return f2bf(lo) | (f2bf(hi) << 16); }
__device__ __forceinline__ float bf2f(unsigned short b) { return __uint_as_float((unsigned)b << 16); }
__device__ __forceinline__ float bflo(unsigned w) { return __uint_as_float(w << 16); }
__device__ __forceinline__ float bfhi(unsigned w) { return __uint_as_float(w & 0xffff0000u); }
__device__ __forceinline__ float silu(float g) { return g / (1.0f + __expf(-g)); }
__device__ __forceinline__ float wave_sum(float v) {
#pragma unroll
    for (int o = 1; o < 64; o <<= 1) v += __shfl_xor(v, o);
    return v;
}
__device__ __forceinline__ float wave_max(float v) {
#pragma unroll
    for (int o = 1; o < 64; o <<= 1) v = fmaxf(v, __shfl_xor(v, o));
    return v;
}
template <int OFF> __device__ __forceinline__ unsigned long long karg64() {
    unsigned long long v; auto ka = __builtin_amdgcn_kernarg_segment_ptr();
    asm volatile("s_load_dwordx2 %0, %1, %2\n\ts_waitcnt lgkmcnt(0)" : "=s"(v) : "s"(ka), "i"(OFF) : "memory");
    return v;
}
#define XB_TMO      128
#define XB_XCNT(j)  (256  + 64 * (j))
#define XB_XSUB(j)  (1280 + 64 * (j))
#define XB_XGEN(j)  (2304 + 64 * (j))
#define XB_TOP      3328
#define XB_TOPGEN   3392
#define XCD_BAR_WORDS 3456
#define XB_SPIN_CAP (1u << 18)

__device__ __forceinline__ unsigned xb_ld(unsigned* p)              { return __hip_atomic_load(p, __ATOMIC_RELAXED, __HIP_MEMORY_SCOPE_AGENT); }
__device__ __forceinline__ unsigned xb_add(unsigned* p, unsigned v) { return __hip_atomic_fetch_add(p, v, __ATOMIC_RELAXED, __HIP_MEMORY_SCOPE_AGENT); }
__device__ __forceinline__ unsigned xb_xcc_id() { return (unsigned)__builtin_amdgcn_s_getreg((3 << 11) | 20) & 0xFu; }
#define XB_SPIN(cond, bar) do { unsigned _sp = 0; while (cond) { __builtin_amdgcn_s_sleep(1); \
    if ((++_sp & 255u) == 0u) { if (xb_ld(&(bar)[XB_TMO])) break; if (_sp > XB_SPIN_CAP) { atomicAdd(&(bar)[XB_TMO], 1u); break; } } } } while (0)

struct XcdBarrier {
    unsigned* bar; unsigned x;
    volatile LAS unsigned* st;
};

__device__ __forceinline__ XcdBarrier xcd_barrier_post(unsigned* bar, volatile LAS unsigned* st) {
    XcdBarrier b; b.bar = bar; b.x = xb_xcc_id(); b.st = st;
    if (threadIdx.x == 0) (void)xb_add(&bar[XB_XCNT(b.x)], 1u);
    return b;
}
__device__ __forceinline__ void xcd_barrier_complete(unsigned* bar, unsigned x, unsigned& nloc, unsigned& nx) {
    const unsigned G = gridDim.x * gridDim.y * gridDim.z;
    unsigned sum, cnt, mine, sp = 0u;
    for (;;) {
        sum = 0u; cnt = 0u; mine = 0u;
#pragma unroll
        for (unsigned j = 0; j < 16; ++j) { const unsigned c = xb_ld(&bar[XB_XCNT(j)]); sum += c; cnt += (c > 0u) ? 1u : 0u; mine = (j == x) ? c : mine; }
        if (sum == G) break;
        __builtin_amdgcn_s_sleep(1);
        if ((++sp & 255u) == 0u) { if (xb_ld(&bar[XB_TMO])) break; if (sp > XB_SPIN_CAP) { atomicAdd(&bar[XB_TMO], 1u); break; } }
    }
    nloc = mine > 0u ? mine : 1u; nx = cnt > 0u ? cnt : 1u;
}

__device__ __forceinline__ void xcd_barrier(const XcdBarrier& b) {
    asm volatile("s_waitcnt vmcnt(0)" ::: "memory");
    __syncthreads();
    if (threadIdx.x == 0) {
        unsigned* bar = b.bar;
        __builtin_amdgcn_s_waitcnt(0);
        unsigned nloc = b.st[0], nx = b.st[1];
        if (nloc == 0u) { xcd_barrier_complete(bar, b.x, nloc, nx); b.st[0] = nloc; b.st[1] = nx; }
        const unsigned old = xb_add(&bar[XB_XSUB(b.x)], 1u);
        const unsigned gen = old / nloc;
        if (old + 1u == (gen + 1u) * nloc) {
            __builtin_amdgcn_fence(__ATOMIC_RELEASE, "agent");
            asm volatile("s_waitcnt vmcnt(0)" ::: "memory");
            const unsigned og = xb_add(&bar[XB_TOP], 1u);
            const unsigned tg = og / nx;
            if (og + 1u == (tg + 1u) * nx) xb_add(&bar[XB_TOPGEN], 1u);
            else XB_SPIN(xb_ld(&bar[XB_TOPGEN]) == tg, bar);
            __builtin_amdgcn_fence(__ATOMIC_ACQUIRE, "agent");
            xb_add(&bar[XB_XGEN(b.x)], 1u);
            asm volatile("s_waitcnt vmcnt(0)" ::: "memory");
        } else {
            XB_SPIN(xb_ld(&bar[XB_XGEN(b.x)]) == gen, bar);
            __builtin_amdgcn_fence(__ATOMIC_ACQUIRE, "agent");
            asm volatile("s_waitcnt vmcnt(0)" ::: "memory");
        }
    }
    __syncthreads();
}
__device__ __forceinline__ void transpose_item(const float* W, int K, int N, bf16* WT, LAS float* scr, int item, int lane) {
    const int nblk = N / 32, kb = item / nblk, nb = item % nblk, k0 = 64 * kb, n0 = 32 * nb;
#pragma unroll 8
    for (int i = 0; i < 32; ++i) { const int kk = 2 * i + (lane >> 5); scr[kk * 33 + (lane & 31)] = W[(size_t)(k0 + kk) * N + n0 + (lane & 31)]; }
    LDS_WAIT(); asm volatile("" ::: "memory");
    const int c = lane & 7;
#pragma unroll
    for (int j = 0; j < 4; ++j) { const int n = (lane >> 3) + 8 * j; const LAS float* s = scr + (8 * c) * 33 + n;
        v4u o; o.x = pk2(s[0 * 33], s[1 * 33]); o.y = pk2(s[2 * 33], s[3 * 33]); o.z = pk2(s[4 * 33], s[5 * 33]); o.w = pk2(s[6 * 33], s[7 * 33]);
        *(GAS v4u*)(WT + (size_t)(n0 + n) * K + k0 + 8 * c) = o; }
    LDS_WAIT(); asm volatile("" ::: "memory");
}
__device__ __forceinline__ void rms_row_to_bf16(const float* xrow, const float* w, bf16* orow, int lane) {
    const GAS f32x4* xr = (const GAS f32x4*)xrow + lane; const GAS f32x4* wr = (const GAS f32x4*)w + lane;
    f32x4 v[4]; float s = 0.f;
#pragma unroll
    for (int j = 0; j < 4; ++j) { v[j] = xr[64 * j]; s += (v[j].x * v[j].x + v[j].y * v[j].y) + (v[j].z * v[j].z + v[j].w * v[j].w); }
    const float rstd = 1.f / sqrtf(wave_sum(s) * (1.f / DM) + RMS_EPS);
    GAS unsigned long long* o8 = (GAS unsigned long long*)orow + lane;
#pragma unroll
    for (int j = 0; j < 4; ++j) { const f32x4 ww = wr[64 * j];
        o8[64 * j] = (unsigned long long)pk2(v[j].x * rstd * ww.x, v[j].y * rstd * ww.y) | ((unsigned long long)pk2(v[j].z * rstd * ww.z, v[j].w * rstd * ww.w) << 32); }
}
__device__ __forceinline__ void rms_row_to_f32(const float* xrow, const float* w, float* orow, int lane) {
    const GAS f32x4* xr = (const GAS f32x4*)xrow + lane; const GAS f32x4* wr = (const GAS f32x4*)w + lane;
    f32x4 v[4]; float s = 0.f;
#pragma unroll
    for (int j = 0; j < 4; ++j) { v[j] = xr[64 * j]; s += (v[j].x * v[j].x + v[j].y * v[j].y) + (v[j].z * v[j].z + v[j].w * v[j].w); }
    const float rstd = 1.f / sqrtf(wave_sum(s) * (1.f / DM) + RMS_EPS);
    GAS f32x4* o = (GAS f32x4*)orow + lane;
#pragma unroll
    for (int j = 0; j < 4; ++j) { const f32x4 ww = wr[64 * j]; o[64 * j] = (v[j] * rstd) * ww; }
}

struct Ptrs {
    const float *xp, *xs, *memp, *mems, *norm_w, *w_in, *w_out, *mem_norm_w, *w_mem_kv, *conv_w, *conv_b, *na_rpb, *final_norm_w;
    float* out;
    bf16 *W1T, *W2T, *WKVT, *MEMN, *MKV, *HB, *Y, *Z;
    unsigned char *KIMG, *VTIMG;
};

__device__ __forceinline__ void phase_prep(const Ptrs& P, LAS unsigned char* lds, int gw, int NGW, int wave, int lane) {
    LAS float* scr = (LAS float*)(lds + RING_OFF + wave * 16384);
    constexpr int I_W1 = (DM / 64) * (INW / 32), I_W2 = (BRW / 64) * (DM / 32), I_KV = (DM / 64) * (DM / 32);
    constexpr int NITEMS = 2 * (I_W1 + I_W2 + I_KV);
    for (int it = gw; it < NITEMS; it += NGW) {
        int r = it;
        if (r < 2 * I_W1) { const int l = r / I_W1; transpose_item(P.w_in + (size_t)l * DM * INW, DM, INW, P.W1T + (size_t)l * INW * DM, scr, r % I_W1, lane); continue; } r -= 2 * I_W1;
        if (r < 2 * I_W2) { const int l = r / I_W2; transpose_item(P.w_out + (size_t)l * BRW * DM, BRW, DM, P.W2T + (size_t)l * DM * BRW, scr, r % I_W2, lane); continue; } r -= 2 * I_W2;
        { const int l = r / I_KV; transpose_item(P.w_mem_kv + (size_t)l * DM * DM, DM, DM, P.WKVT + (size_t)l * DM * DM, scr, r % I_KV, lane); }
    }
    for (int m = gw; m < 2 * MEMROWS; m += NGW) { const int l = m / MEMROWS, r = m % MEMROWS;
        const float* src = (r < 1024) ? P.memp + (size_t)r * DM : P.mems + (size_t)(r - 1024) * DM;
        rms_row_to_bf16(src, P.mem_norm_w + l * DM, P.MEMN + (size_t)m * DM, lane); }
    for (int m = gw; m < TOK; m += NGW) { const float* src = (m < 32768) ? P.xp + (size_t)m * DM : P.xs + (size_t)(m - 32768) * DM;
        rms_row_to_bf16(src, P.norm_w, P.HB + (size_t)m * DM, lane); }
}

__device__ __forceinline__ void phase_conv(const Ptrs& P, int chunk, int gt, int NGT) {
    const int seqlen = (chunk == 2) ? 16384 : 8192;
    const bf16* z = P.Z; bf16* y = P.Y;
    for (int it = gt; it < CH * (MIXW / 8); it += NGT) {
        const int tl = it / (MIXW / 8), cg = it % (MIXW / 8), ch = cg * 8;
        const int ts = tl % seqlen; const bool hp = ts > 0, hn = ts < seqlen - 1;
        const bf16* zr = z + (size_t)tl * INW + ch;
        const v4u p0 = *(const GAS v4u*)(zr + ZQ), p1 = *(const GAS v4u*)(zr + ZK), p2 = *(const GAS v4u*)(zr + ZV), gg = *(const GAS v4u*)(zr + ZG);
        v4u a1 = (v4u){0, 0, 0, 0}, a2 = a1, b1 = a1, b2 = a1;
        if (hp) { a1 = *(const GAS v4u*)(zr - INW + ZK); a2 = *(const GAS v4u*)(zr - INW + ZV); }
        if (hn) { b1 = *(const GAS v4u*)(zr + INW + ZK); b2 = *(const GAS v4u*)(zr + INW + ZV); }
        float cw0[8], cw1[8], cw2[8], cb[8];
#pragma unroll
        for (int j = 0; j < 8; ++j) { cw0[j] = P.conv_w[ch + j]; cw1[j] = P.conv_w[MIXW + ch + j]; cw2[j] = P.conv_w[2 * MIXW + ch + j]; cb[j] = P.conv_b[ch + j]; }
        v4u o;
#pragma unroll
        for (int w = 0; w < 4; ++w) {
            float r[2];
#pragma unroll
            for (int e = 0; e < 2; ++e) {
                const int j = 2 * w + e;
                const float vp = e ? bfhi(a1[w]) * bfhi(a2[w]) : bflo(a1[w]) * bflo(a2[w]);
                const float vc = e ? bfhi(p1[w]) * bfhi(p2[w]) : bflo(p1[w]) * bflo(p2[w]);
                const float vn = e ? bfhi(b1[w]) * bfhi(b2[w]) : bflo(b1[w]) * bflo(b2[w]);
                const float conv = vp * cw0[j] + vc * cw1[j] + vn * cw2[j] + cb[j];
                const float b = e ? bfhi(p0[w]) : bflo(p0[w]);
                const float g = e ? bfhi(gg[w]) : bflo(gg[w]);
                r[e] = b * conv * silu(g);
            }
            o[w] = pk2(r[0], r[1]);
        }
        *(GAS v4u*)(y + (size_t)tl * BRW + ch) = o;
    }
}

__device__ __forceinline__ void phase_na_naive(const Ptrs& P, int chunk, int gw, int NGW, int lane) {
    const int seqlen = (chunk == 2) ? 16384 : 8192; const int rows = seqlen / 64;
    const bf16* z = P.Z; bf16* y = P.Y; const float* rpb = P.na_rpb;
    for (int task = gw; task < CH * NAH; task += NGW) {
        const int tl = task / NAH, h = task % NAH;
        const int ss = (tl / seqlen) * seqlen, ts = tl - ss, r = ts >> 6, c = ts & 63;
        int r0 = r - 4; r0 = r0 < 0 ? 0 : (r0 > rows - 8 ? rows - 8 : r0);
        int c0 = c - 8; c0 = c0 < 0 ? 0 : (c0 > 48 ? 48 : c0);
        v4u qv[8];
        { const GAS v4u* qp = (const GAS v4u*)(z + (size_t)tl * INW + ZQ + h * 64);
#pragma unroll
          for (int i = 0; i < 8; ++i) qv[i] = qp[i]; }
        float lg[2];
#pragma unroll
        for (int u = 0; u < 2; ++u) {
            const int kk = lane + 64 * u, a = kk >> 4, j = kk & 15;
            const int kt = ss + (r0 + a) * 64 + c0 + j;
            const GAS v4u* kp = (const GAS v4u*)(z + (size_t)kt * INW + ZK + h * 64);
            float dot = 0.f;
#pragma unroll
            for (int i = 0; i < 8; ++i) { const v4u kv = kp[i];
#pragma unroll
                for (int w = 0; w < 4; ++w) dot += bflo(qv[i][w]) * bflo(kv[w]) + bfhi(qv[i][w]) * bfhi(kv[w]); }
            lg[u] = dot * 0.125f + rpb[(h * 15 + (r0 + a - r + 7)) * 31 + (c0 + j - c + 15)];
        }
        const float mx = wave_max(fmaxf(lg[0], lg[1]));
        float pe[2]; pe[0] = __expf(lg[0] - mx); pe[1] = __expf(lg[1] - mx);
        const float inv = 1.f / wave_sum(pe[0] + pe[1]);
        pe[0] *= inv; pe[1] *= inv;
        float o = 0.f;
#pragma unroll
        for (int u = 0; u < 2; ++u)
            for (int kl = 0; kl < 64; ++kl) {
                const float p = __shfl(pe[u], kl);
                const int kk = kl + 64 * u, a = kk >> 4, j = kk & 15;
                const int kt = ss + (r0 + a) * 64 + c0 + j;
                o += p * bf2f(z[(size_t)kt * INW + ZV + h * 64 + lane]);
            }
        const float g = bf2f(z[(size_t)tl * INW + ZG + h * 64 + lane]);
        y[(size_t)tl * BRW + h * 64 + lane] = (bf16)f2bf(o * silu(g));
    }
}

__device__ __forceinline__ void phase_xattn_naive(const Ptrs& P, int layer, int chunk, int gw, int NGW, int lane) {
    const bf16* z = P.Z; bf16* y = P.Y;
    for (int task = gw; task < CH * XH; task += NGW) {
        const int tl = task / XH, h = task % XH;
        const int g = chunk * CH + tl, s = (g < 32768) ? (g >> 13) : 4;
        const bf16* kb = P.MKV + ((size_t)layer * MEMROWS + s * 256) * DM + h * 128;
        const bf16* vb = kb + 512;
        v4u qv[16];
        { const GAS v4u* qp = (const GAS v4u*)(z + (size_t)tl * INW + ZQM + h * 128);
#pragma unroll
          for (int i = 0; i < 16; ++i) qv[i] = qp[i]; }
        float lg[4];
#pragma unroll
        for (int u = 0; u < 4; ++u) {
            const int key = lane + 64 * u;
            const GAS v4u* kp = (const GAS v4u*)(kb + (size_t)key * DM);
            float dot = 0.f;
#pragma unroll
            for (int i = 0; i < 16; ++i) { const v4u kv = kp[i];
#pragma unroll
                for (int w = 0; w < 4; ++w) dot += bflo(qv[i][w]) * bflo(kv[w]) + bfhi(qv[i][w]) * bfhi(kv[w]); }
            lg[u] = dot * 0.08838834764831845f;
        }
        const float mx = wave_max(fmaxf(fmaxf(lg[0], lg[1]), fmaxf(lg[2], lg[3])));
        float pe[4]; float sm = 0.f;
#pragma unroll
        for (int u = 0; u < 4; ++u) { pe[u] = __expf(lg[u] - mx); sm += pe[u]; }
        const float inv = 1.f / wave_sum(sm);
        float o0 = 0.f, o1 = 0.f;
#pragma unroll
        for (int u = 0; u < 4; ++u)
            for (int kl = 0; kl < 64; ++kl) {
                const float p = __shfl(pe[u], kl) * inv;
                const unsigned vv = *(const GAS unsigned*)(vb + (size_t)(kl + 64 * u) * DM + 2 * lane);
                o0 += p * bflo(vv); o1 += p * bfhi(vv);
            }
        const unsigned gg = *(const GAS unsigned*)(z + (size_t)tl * INW + ZG + MIXW + h * 128 + 2 * lane);
        *(GAS unsigned*)(y + (size_t)tl * BRW + MIXW + h * 128 + 2 * lane) = pk2(o0 * silu(bflo(gg)), o1 * silu(bfhi(gg)));
    }
}
namespace xa {
typedef short bf16x8 __attribute__((ext_vector_type(8)));
typedef float f32x16 __attribute__((ext_vector_type(16)));
typedef float f32x2_t __attribute__((ext_vector_type(2))); typedef __bf16 bf16x2_t __attribute__((ext_vector_type(2)));
typedef unsigned u32x4 __attribute__((ext_vector_type(4)));
__device__ __forceinline__ int crow(int r, int h) { return (r & 3) + 8 * (r >> 2) + 4 * h; }
__device__ __forceinline__ unsigned cvtpk(float lo, float hi) { f32x2_t v = {lo, hi}; bf16x2_t b = __builtin_convertvector(v, bf16x2_t); return __builtin_bit_cast(unsigned, b); }
__device__ __forceinline__ int pos2key16(int p) { return 8 * ((p & 7) >> 2) + 4 * (p >> 3) + (p & 3); }
constexpr int XSCR_OFF = RING_BYTES + 1024;
constexpr float C2 = 0.08838834764831845f * 1.4426950408889634f;

__device__ __forceinline__ void xattn_unit(LAS unsigned char* lds, const bf16* z, bf16* y, int row0, int h, const unsigned char* kimg, const unsigned char* vtimg, int tid) {
    const int lane = tid & 63, wid = __builtin_amdgcn_readfirstlane(tid >> 6), r32 = lane & 31, hh = lane >> 5;
    { const unsigned char* src = (wid < 4 ? kimg : vtimg - 65536) + (size_t)wid * 16384 + lane * 16;
#pragma unroll
      for (int i = 0; i < 16; ++i) __builtin_amdgcn_global_load_lds((const GAS unsigned*)(src + i * 1024), (LAS unsigned*)(lds + wid * 16384 + i * 1024), 16, 0, 0); }
    bf16x8 qf[8];
    { const bf16* qp = z + (size_t)(row0 + wid * 32 + r32) * INW + ZQM + h * 128 + hh * 8;
#pragma unroll
      for (int ks = 0; ks < 8; ++ks) qf[ks] = *(const GAS bf16x8*)(qp + ks * 16); }
    asm volatile("s_waitcnt vmcnt(0)" ::: "memory");
    __syncthreads();
    f32x16 s[8];
#pragma unroll
    for (int kb = 0; kb < 8; ++kb) {
        const int key = kb * 32 + r32;
        f32x16 acc;
#pragma unroll
        for (int i = 0; i < 16; ++i) acc[i] = 0.f;
#pragma unroll
        for (int ks = 0; ks < 8; ++ks) {
            const bf16x8 a = *(const LAS bf16x8*)(lds + key * 256 + (((2 * ks + hh) ^ (key & 15)) << 4));
            acc = __builtin_amdgcn_mfma_f32_32x32x16_bf16(a, qf[ks], acc, 0, 0, 0);
        }
        s[kb] = acc;
    }
    float m = s[0][0];
#pragma unroll
    for (int kb = 0; kb < 8; ++kb)
#pragma unroll
        for (int r = 0; r < 16; ++r) m = fmaxf(m, s[kb][r]);
    m = fmaxf(m, __shfl_xor(m, 32));
    const float mc = m * C2;
    float lsum = 0.f;
#pragma unroll
    for (int kb = 0; kb < 8; ++kb)
#pragma unroll
        for (int r = 0; r < 16; ++r) { const float p = __builtin_amdgcn_exp2f(s[kb][r] * C2 - mc); s[kb][r] = p; lsum += p; }
    lsum += __shfl_xor(lsum, 32);
    __syncthreads();
    f32x16 o[4];
#pragma unroll
    for (int db = 0; db < 4; ++db)
#pragma unroll
        for (int i = 0; i < 16; ++i) o[db][i] = 0.f;
#pragma unroll
    for (int kb = 0; kb < 8; ++kb)
#pragma unroll
        for (int st = 0; st < 2; ++st) {
            u32x4 pw;
#pragma unroll
            for (int j = 0; j < 4; ++j) pw[j] = cvtpk(s[kb][8 * st + 2 * j], s[kb][8 * st + 2 * j + 1]);
            const bf16x8 pa = __builtin_bit_cast(bf16x8, pw);
            const int c = 4 * kb + 2 * st + hh;
#pragma unroll
            for (int db = 0; db < 4; ++db) {
                const int d = db * 32 + r32;
                const bf16x8 b = *(const LAS bf16x8*)(lds + 65536 + d * 512 + ((((c & 15) ^ (d & 15)) | (c & 16)) << 4));
                o[db] = __builtin_amdgcn_mfma_f32_32x32x16_bf16(pa, b, o[db], 0, 0, 0);
            }
        }
    LAS float* lsc = (LAS float*)(lds + XSCR_OFF + wid * 128);
    if (hh == 0) lsc[r32] = lsum;
    asm volatile("s_waitcnt lgkmcnt(0)" ::: "memory");
    LAS bf16* stg = (LAS bf16*)(lds + wid * 8192);
#pragma unroll
    for (int r = 0; r < 16; ++r) {
        const int q = crow(r, hh); const float rl = 1.0f / lsc[q];
#pragma unroll
        for (int db = 0; db < 4; ++db) stg[q * 128 + db * 32 + r32] = (bf16)f2bf(o[db][r] * rl);
    }
    asm volatile("s_waitcnt lgkmcnt(0)" ::: "memory");
#pragma unroll
    for (int i = 0; i < 8; ++i) {
        const int idx = i * 64 + lane, row = idx >> 4, ch = idx & 15;
        const u32x4 ov = *(const LAS u32x4*)(stg + row * 128 + ch * 8);
        const size_t grow = (size_t)(row0 + wid * 32 + row);
        const u32x4 gv = *(const GAS u32x4*)(z + grow * INW + ZG + MIXW + h * 128 + ch * 8);
        u32x4 w;
#pragma unroll
        for (int j = 0; j < 4; ++j) w[j] = pk2(bflo(ov[j]) * silu(bflo(gv[j])), bfhi(ov[j]) * silu(bfhi(gv[j])));
        *(GAS u32x4*)(y + grow * BRW + MIXW + h * 128 + ch * 8) = w;
    }
    __syncthreads();
}
}

__device__ __forceinline__ void phase_img(const bf16* MKV, unsigned char* KIMG, unsigned char* VTIMG, int gt, int NGT) {
    for (int it = gt; it < 40 * 4096; it += NGT) {
        const int img = it >> 12, key = (it >> 4) & 255, c = it & 15, ls = img >> 2, h = img & 3;
        const v4u v = *(const GAS v4u*)(MKV + ((size_t)ls * 256 + key) * DM + h * 128 + c * 8);
        *(GAS v4u*)(KIMG + (size_t)img * 65536 + key * 256 + ((c ^ (key & 15)) << 4)) = v;
    }
    for (int it = gt; it < 40 * 4096; it += NGT) {
        const int img = it >> 12, d = (it >> 5) & 127, c = it & 31, ls = img >> 2, h = img & 3;
        const bf16* vsrc = MKV + (size_t)ls * 256 * DM + 512 + h * 128 + d;
        unsigned short e[8];
#pragma unroll
        for (int j = 0; j < 8; ++j) { const int p = c * 8 + j, key = (p & ~15) + xa::pos2key16(p & 15); e[j] = vsrc[(size_t)key * DM]; }
        v4u v; v.x = e[0] | ((unsigned)e[1] << 16); v.y = e[2] | ((unsigned)e[3] << 16); v.z = e[4] | ((unsigned)e[5] << 16); v.w = e[6] | ((unsigned)e[7] << 16);
        *(GAS v4u*)(VTIMG + (size_t)img * 65536 + d * 512 + ((((c & 15) ^ (d & 15)) | (c & 16)) << 4)) = v;
    }
}
struct Args { const float* in[13]; float* out; unsigned char* ws; int ph_lo, ph_hi; };
__global__ void __launch_bounds__(NWAVES * 64, 2) fwd_kernel(Args args) {
    extern __shared__ __attribute__((aligned(16))) unsigned char lds_raw[];
    LAS unsigned char* lds = (LAS unsigned char*)lds_raw;
    volatile LAS unsigned* MISC = (volatile LAS unsigned*)(lds + MISC_OFF);
#define KARG(off) karg64<(off)>()
#define LOAD_PTRS() Ptrs P; do { unsigned char* ws_ = (unsigned char*)(GAS unsigned char*)KARG(112); \
    P.xp = (const float*)(const GAS float*)KARG(0); P.xs = (const float*)(const GAS float*)KARG(8); P.memp = (const float*)(const GAS float*)KARG(16); P.mems = (const float*)(const GAS float*)KARG(24); P.norm_w = (const float*)(const GAS float*)KARG(32); \
    P.w_in = (const float*)(const GAS float*)KARG(40); P.w_out = (const float*)(const GAS float*)KARG(48); P.mem_norm_w = (const float*)(const GAS float*)KARG(56); P.w_mem_kv = (const float*)(const GAS float*)KARG(64); P.conv_w = (const float*)(const GAS float*)KARG(72); \
    P.conv_b = (const float*)(const GAS float*)KARG(80); P.na_rpb = (const float*)(const GAS float*)KARG(88); P.final_norm_w = (const float*)(const GAS float*)KARG(96); P.out = (float*)(GAS float*)KARG(104); \
    P.W1T = (bf16*)(ws_ + WS_W1T); P.W2T = (bf16*)(ws_ + WS_W2T); P.WKVT = (bf16*)(ws_ + WS_WKVT); P.MEMN = (bf16*)(ws_ + WS_MEMN); P.MKV = (bf16*)(ws_ + WS_MKV); \
    P.HB = (bf16*)(ws_ + WS_HB); P.Y = (bf16*)(ws_ + WS_Y); P.Z = (bf16*)(ws_ + WS_Z); P.KIMG = ws_ + WS_KIMG; P.VTIMG = ws_ + WS_VTIMG; } while (0)
    for (int u = threadIdx.x; u < (LDS_BYTES - LDSCTL_OFF) / 4; u += NWAVES * 64) ((LAS unsigned*)(lds + LDSCTL_OFF))[u] = 0u;
    __syncthreads();
    const int lo = args.ph_lo, hi = args.ph_hi;
    if (hi - lo > 1) (void)xcd_barrier_post((unsigned*)((gu32*)((GAS unsigned char*)KARG(112) + WS_CTL) + CW_BAR), MISC + 8);

    for (int ph = lo; ph < hi; ++ph) {
        int tid = threadIdx.x; asm volatile("" : "+v"(tid));
        int bx = blockIdx.x; asm volatile("" : "+s"(bx));
        int G = gridDim.x; asm volatile("" : "+s"(G));
        const int lane = tid & 63, wave = __builtin_amdgcn_readfirstlane(tid >> 6);
        const int vcu = (G % 8 == 0) ? (bx % 8) * (G / 8) + bx / 8 : bx;
        const int gw = vcu * NWAVES + wave, NGW = G * NWAVES;
        const int gt = vcu * (NWAVES * 64) + tid, NGT = G * NWAVES * 64;
        LOAD_PTRS();
        if (ph == PH_PREP) {
            phase_prep(P, lds, gw, NGW, wave, lane);
        } else if (ph == PH_MKV) {
            for (int l = 0; l < 2; ++l) {
                pg8::Gemm g{P.MEMN + (size_t)l * MEMROWS * DM, P.WKVT + (size_t)l * DM * DM, MEMROWS, DM, DM};
                pg8::StaticOrder S; S.init(MEMROWS, DM, G, (bx + 128 * l) % G);
                pg8::EpiBf16<0> E{P.MKV + (size_t)l * MEMROWS * DM, DM, nullptr, 0, 0, 1.f};
                pg8::gemm_phase<pg8::EpiBf16<0>, pg8::StaticOrder, true, true>(lds + RING_OFF, g, S, E, tid);
            }
        } else if (ph == PH_IMG) {
            phase_img(P.MKV, P.KIMG, P.VTIMG, gt, NGT);
        } else {
            const int q = ph - PH_L0, layer = q / PH_PER_LAYER, r = q % PH_PER_LAYER;
            if (r == 9) {
                if (layer == 0) { for (int m = gw; m < TOK; m += NGW) rms_row_to_bf16(P.out + (size_t)m * DM, P.norm_w + DM, P.HB + (size_t)m * DM, lane); }
                else { for (int m = gw; m < TOK; m += NGW) rms_row_to_f32(P.out + (size_t)m * DM, P.final_norm_w, P.out + (size_t)m * DM, lane); }
            } else {
                const int chunk = r / 3, kind = r % 3;
                if (kind == 0) {
                    pg8::Gemm g{P.HB + (size_t)chunk * CH * DM, P.W1T + (size_t)layer * INW * DM, CH, INW, DM};
                    pg8::StaticOrder S; S.init(CH, INW, G, bx);
                    pg8::EpiBf16<0> E{P.Z, INW, nullptr, 0, 0, 1.f};
                    pg8::gemm_phase<pg8::EpiBf16<0>, pg8::StaticOrder, true, true>(lds + RING_OFF, g, S, E, tid);
                } else if (kind == 1) {
                    if (layer == 0) phase_conv(P, chunk, gt, NGT); else phase_na_naive(P, chunk, gw, NGW, lane);
                    for (int u = vcu; u < (CH / 256) * XH; u += G) {
                        const int pm = u >> 2, h = u & 3, grow = chunk * CH + pm * 256, seq = (grow < 32768) ? (grow >> 13) : 4, img = (layer * 5 + seq) * 4 + h;
                        xa::xattn_unit(lds, P.Z, P.Y, pm * 256, h, P.KIMG + (size_t)img * 65536, P.VTIMG + (size_t)img * 65536, tid);
                    }
                } else {
                    const float* base = (layer == 0) ? ((chunk < 2) ? P.xp + (size_t)chunk * CH * DM : P.xs) : P.out + (size_t)chunk * CH * DM;
                    pg8::Gemm g{P.Y, P.W2T + (size_t)layer * DM * BRW, CH, DM, BRW};
                    pg8::StaticOrder S; S.init(CH, DM, G, bx);
                    pg8::EpiResF32 E{base, P.out + (size_t)chunk * CH * DM, DM};
                    pg8::gemm_phase<pg8::EpiResF32, pg8::StaticOrder, true, true>(lds + RING_OFF, g, S, E, tid);
                }
            }
        }
        if (ph + 1 < hi) { XcdBarrier bar; bar.bar = (unsigned*)((gu32*)((GAS unsigned char*)KARG(112) + WS_CTL) + CW_BAR); bar.x = xb_xcc_id(); bar.st = MISC + 8; xcd_barrier(bar); }
    }
}

extern "C" void kernel_launch(void* const* d_in, const int* in_sizes, int n_in, void* d_out, int out_size, void* d_ws, size_t ws_size, hipStream_t stream) {
    static int grid = 0;
    if (grid == 0) {
        if (n_in != 13 || out_size != TOK * DM || ws_size < WS_END) { fprintf(stderr, "kernel_launch: unexpected shapes (n_in %d out %d ws %zu)\n", n_in, out_size, ws_size); grid = -1; return; }
        int dev = 0, cus = 0, per_cu = 0;
        if (hipGetDevice(&dev) != hipSuccess || hipDeviceGetAttribute(&cus, hipDeviceAttributeMultiprocessorCount, dev) != hipSuccess) { grid = -1; return; }
        if (hipFuncSetAttribute((const void*)fwd_kernel, hipFuncAttributeMaxDynamicSharedMemorySize, LDS_BYTES) != hipSuccess) { fprintf(stderr, "kernel_launch: hipFuncSetAttribute failed\n"); grid = -1; return; }
        if (hipOccupancyMaxActiveBlocksPerMultiprocessor(&per_cu, (const void*)fwd_kernel, NWAVES * 64, LDS_BYTES) != hipSuccess || per_cu < 1) { fprintf(stderr, "kernel_launch: occupancy query says %d\n", per_cu); per_cu = 1; }
        (void)hipGetLastError();
        grid = cus;
    }
    if (grid < 0) return;
    (void)hipMemsetAsync((char*)d_ws + WS_CTL, 0, CTL_ZERO_BYTES, stream);
    Args a{};
    for (int i = 0; i < 13; ++i) a.in[i] = (const float*)d_in[i];
    a.out = (float*)d_out; a.ws = (unsigned char*)d_ws;
#if MK_ONE_LAUNCH
    a.ph_lo = 0; a.ph_hi = NPHASE;
    hipLaunchKernelGGL(fwd_kernel, dim3(grid), dim3(NWAVES * 64), LDS_BYTES, stream, a);
#else
    for (int ph = 0; ph < NPHASE; ++ph) { a.ph_lo = ph; a.ph_hi = ph + 1;
        hipLaunchKernelGGL(fwd_kernel, dim3(grid), dim3(NWAVES * 64), LDS_BYTES, stream, a); }
#endif
}
```

```cpp
#include <hip/hip_runtime.h>
#include <cstdio>
#include <cstdint>
namespace pg8 {
#define PG8_LAS __attribute__((address_space(3)))
typedef unsigned short bf16_t;
typedef short bf16x8 __attribute__((ext_vector_type(8)));
typedef float f32x4 __attribute__((ext_vector_type(4)));
typedef unsigned u32x4 __attribute__((ext_vector_type(4)));
constexpr int BM = 256, BK = 64, HALF = 128, HTB = HALF * BK * 2  , STAGE_BYTES = 8 * HTB, NXCD = 8, WGM = 8;

__host__ __device__ __forceinline__ int lds_byte(int r, int c) { const int st = (r >> 4) * 2 + (c >> 5), rr = r & 15, cc = c & 31, ob = rr * 64 + cc * 2; return st * 1024 + (ob ^ (((ob >> 9) & 1) << 5)); }
__host__ __device__ __forceinline__ void stage_rc(int b, int& R, int& C) { const int st = b / 1024, sb = b % 1024, swz = sb ^ (((sb >> 9) & 1) << 5); R = (st >> 1) * 16 + swz / 64; C = (st & 1) * 32 + (swz % 64) / 2; }
__host__ __device__ __forceinline__ int perm32(int rho) { const int n = rho >> 4, i = rho & 15; return 8 * (i >> 2) + 4 * n + (i & 3); }

struct Unit { int pm, pn; };
struct Gemm { const bf16_t* A; const bf16_t* Bt; int M, N, K; };

struct StaticOrder {
    int nM, nN, nwg, G, c;
    __host__ __device__ void init(int M, int N, int G_, int c_) { nM = M / BM; nN = N / BM; nwg = nM * nN; G = G_; c = c_; }
    __host__ __device__ bool next(int i, Unit& u) const {
        const long L = (long)i * G + c; if (L >= nwg) return false;
        int wgid = (int)L; { const int q = nwg / NXCD, r = nwg % NXCD, xcd = wgid % NXCD, off = wgid / NXCD; wgid = (xcd < r ? xcd * (q + 1) : r * (q + 1) + (xcd - r) * q) + off; }
        const int nig = WGM * nN, gid = wgid / nig, fm = gid * WGM, gsz = (nM - fm) < WGM ? (nM - fm) : WGM;
        u.pm = fm + ((wgid % nig) % gsz); u.pn = (wgid % nig) / gsz; return true;
    }
    __device__ __forceinline__ void a_ready(const Unit&) const {}
    __device__ __forceinline__ void done(const Unit&) const {}
};

__device__ __forceinline__ unsigned cvt_pk_bf16(float lo, float hi) { unsigned r; asm volatile("v_cvt_pk_bf16_f32 %0, %1, %2" : "=v"(r) : "v"(lo), "v"(hi)); return r; }
typedef float f32x2 __attribute__((ext_vector_type(2)));
__device__ __forceinline__ f32x2 gelu_pk(f32x2 v) {
    const f32x2 av = __builtin_elementwise_abs(v), d = av * 0.2316418882f + 1.0f;
    f32x2 t; t.x = __builtin_amdgcn_rcpf(d.x); t.y = __builtin_amdgcn_rcpf(d.y);
    f32x2 q = t * 0.5307027145f + (-0.7265760135f); q = q * t + 0.7107068705f; q = q * t + (-0.142248368f); q = q * t + 0.127414796f; q = q * t;
    const f32x2 s = (v * v) * (-0.72134752044f);
    f32x2 e; e.x = __builtin_amdgcn_exp2f(s.x); e.y = __builtin_amdgcn_exp2f(s.y);
    const f32x2 m = v * (q * e), r = v - m;
    f32x2 o; o.x = v.x < 0.f ? m.x : r.x; o.y = v.y < 0.f ? m.y : r.y; return o;
}

template <int ACT  > struct EpiBf16 {
    static constexpr bool PERM = true, AFTER_DRAIN = false; static_assert(ACT == 0 || ACT == 1, "EpiBf16: ACT is 0 (none) or 1 (gelu_pk)");
    bf16_t* O; int ldc; const float* bias; int split_cols; size_t split_stride; float scale0;
    __device__ __forceinline__ void operator()(const f32x4 (&acc)[2][2][4][2], const Unit& u, int wr, int wc, int fr, int fq) const {
        const int row0 = u.pm * BM + wr * 64 + fr; int colt = u.pn * BM; bf16_t* base = O;
        float sc = 1.f; if (split_cols) { const int t = colt / split_cols; base += (size_t)t * split_stride; colt -= t * split_cols; if (t == 0) sc = scale0; }
        const int col0 = colt + wc * 32 + 8 * fq, bcol0 = u.pn * BM + wc * 32 + 8 * fq;
        f32x4 bv[2][2];
#pragma unroll
        for (int bj = 0; bj < 2; ++bj)
#pragma unroll
            for (int n = 0; n < 2; ++n) bv[bj][n] = bias ? *(const f32x4*)(bias + bcol0 + bj * HALF + 4 * n) : (f32x4){0.f, 0.f, 0.f, 0.f};
#pragma unroll
        for (int ai = 0; ai < 2; ++ai)
#pragma unroll
            for (int m = 0; m < 4; ++m) { bf16_t* rowp = base + (size_t)(row0 + ai * HALF + m * 16) * ldc + col0;
#pragma unroll
                for (int bj = 0; bj < 2; ++bj) { f32x4 v0 = acc[ai][bj][m][0] + bv[bj][0], v1 = acc[ai][bj][m][1] + bv[bj][1];
                    if (ACT == 1) { f32x2 a = gelu_pk((f32x2){v0[0], v0[1]}), b = gelu_pk((f32x2){v0[2], v0[3]}), c = gelu_pk((f32x2){v1[0], v1[1]}), d = gelu_pk((f32x2){v1[2], v1[3]});
                        v0 = (f32x4){a.x, a.y, b.x, b.y}; v1 = (f32x4){c.x, c.y, d.x, d.y}; }
                    v0 = v0 * sc; v1 = v1 * sc; u32x4 w; w.x = cvt_pk_bf16(v0[0], v0[1]); w.y = cvt_pk_bf16(v0[2], v0[3]); w.z = cvt_pk_bf16(v1[0], v1[1]); w.w = cvt_pk_bf16(v1[2], v1[3]);
                    *(u32x4*)(rowp + bj * HALF) = w; } }
    }
};
struct EpiResF32 {
    static constexpr bool PERM = false, AFTER_DRAIN = false;
    const float* base; float* out; int ldc;
    __device__ __forceinline__ void operator()(const f32x4 (&acc)[2][2][4][2], const Unit& u, int wr, int wc, int fr, int fq) const {
        const int row0 = u.pm * BM + wr * 64 + fr, col0 = u.pn * BM + wc * 32 + 4 * fq;
#pragma unroll
        for (int ai = 0; ai < 2; ++ai)
#pragma unroll
            for (int m = 0; m < 4; ++m) { const size_t off = (size_t)(row0 + ai * HALF + m * 16) * ldc + col0;
#pragma unroll
                for (int bj = 0; bj < 2; ++bj)
#pragma unroll
                    for (int n = 0; n < 2; ++n) { const f32x4 bs = *(const f32x4*)(base + off + bj * HALF + n * 16); *(f32x4*)(out + off + bj * HALF + n * 16) = bs + acc[ai][bj][m][n]; }
                if (m & 1) asm volatile("" ::: "memory"); }
    }
};
template <class Epi, class Sched, bool ALIGN_EPI = false, bool SP2 = false>
__device__ __forceinline__ void gemm_phase(PG8_LAS unsigned char* lds, const Gemm g, const Sched& S, const Epi& E, const int tid) {
    const int wid = __builtin_amdgcn_readfirstlane(tid >> 6), lane = tid & 63, wr = wid >> 2, wc = wid & 3, fr = lane & 15, fq = lane >> 4;
    const int K = g.K, nt = K / BK;
    unsigned voffA[2], voffB[2];
#pragma unroll
    for (int i = 0; i < 2; ++i) { int R, C; stage_rc(tid * 16 + i * 8192, R, C); const int Rb = Epi::PERM ? ((R & ~31) + perm32(R & 31)) : R;
        voffA[i] = (unsigned)(R * K + C) * 2u; voffB[i] = (unsigned)(Rb * K + C) * 2u; }
    const size_t kstep = (size_t)(BK * 2);
    const size_t hstep = (size_t)HALF * K * 2;
    const size_t tstep = 2 * hstep;
    const unsigned ldsw = (unsigned)wid * 1024u;
    const int aoff = lds_byte(wr * 64 + fr, fq * 8), boff = lds_byte(wc * 32 + fr, fq * 8);
#define PG8_SA(b, h) (((b) * 2 + (h)) * HTB)
#define PG8_SB(b, h) ((4 + (b) * 2 + (h)) * HTB)
#define PG8_STAGE(bufoff, gbase, voff) do { _Pragma("unroll") for (int _i = 0; _i < 2; ++_i) \
        __builtin_amdgcn_global_load_lds((const unsigned*)((const char*)(gbase) + (voff)[_i]), (PG8_LAS unsigned*)(lds + (bufoff) + ldsw + _i * 8192), 16, 0, 0); } while (0)
#define PG8_LDA(dst, b, h) do { _Pragma("unroll") for (int m = 0; m < 4; ++m) _Pragma("unroll") for (int k = 0; k < 2; ++k) dst[m][k] = *(const PG8_LAS bf16x8*)(lds + PG8_SA(b, h) + aoff + m * 2048 + k * 1024); } while (0)
#define PG8_LDB(dst, b, h) do { _Pragma("unroll") for (int n = 0; n < 2; ++n) _Pragma("unroll") for (int k = 0; k < 2; ++k) dst[n][k] = *(const PG8_LAS bf16x8*)(lds + PG8_SB(b, h) + boff + n * 2048 + k * 1024); } while (0)
#define PG8_MMA(ai, bj, At, Bt) do { __builtin_amdgcn_s_setprio(1); _Pragma("unroll") for (int m = 0; m < 4; ++m) _Pragma("unroll") for (int n = 0; n < 2; ++n) _Pragma("unroll") for (int k = 0; k < 2; ++k) \
        acc[ai][bj][m][n] = __builtin_amdgcn_mfma_f32_16x16x32_bf16(Bt[n][k], At[m][k], acc[ai][bj][m][n], 0, 0, 0); __builtin_amdgcn_s_setprio(0); } while (0)
#define PG8_WAIT_V(n) asm volatile("s_waitcnt vmcnt(" #n ")" ::: "memory")
#define PG8_WAIT_L(n) asm volatile("s_waitcnt lgkmcnt(" #n ")" ::: "memory")
#define PG8_BAR __builtin_amdgcn_s_barrier()
#define PG8_SCHED __builtin_amdgcn_sched_barrier(0)
    Unit cur, nxt; int ui = 0;
    if (!S.next(0, cur)) return;
    f32x4 acc[2][2][4][2];
#pragma unroll
    for (int a = 0; a < 2; ++a)
#pragma unroll
        for (int b = 0; b < 2; ++b)
#pragma unroll
            for (int m = 0; m < 4; ++m)
#pragma unroll
                for (int n = 0; n < 2; ++n) acc[a][b][m][n] = (f32x4){0.f, 0.f, 0.f, 0.f};
    bf16x8 At[4][2], B0[2][2], B1[2][2];
    const char* cA = (const char*)g.A + (size_t)cur.pm * tstep; const char* cB = (const char*)g.Bt + (size_t)cur.pn * tstep;
    S.a_ready(cur);
    if constexpr (SP2) {
        PG8_STAGE(PG8_SB(0, 0), cB, voffB); PG8_STAGE(PG8_SB(0, 1), cB + hstep, voffB); PG8_STAGE(PG8_SA(0, 0), cA, voffA); PG8_STAGE(PG8_SA(0, 1), cA + hstep, voffA);
        if (wr == 1) PG8_BAR;
        PG8_WAIT_V(2); PG8_BAR;
        PG8_STAGE(PG8_SB(1, 0), cB + kstep, voffB); PG8_STAGE(PG8_SA(1, 0), cA + kstep, voffA); PG8_STAGE(PG8_SB(1, 1), cB + hstep + kstep, voffB);
        PG8_WAIT_V(6); PG8_BAR;
    } else {
        PG8_STAGE(PG8_SB(0, 0), cB, voffB); PG8_STAGE(PG8_SA(0, 0), cA, voffA); PG8_STAGE(PG8_SB(0, 1), cB + hstep, voffB); PG8_STAGE(PG8_SA(0, 1), cA + hstep, voffA);
        if (wr == 1) PG8_BAR;
        PG8_WAIT_V(4); PG8_BAR;
        PG8_STAGE(PG8_SB(1, 0), cB + kstep, voffB); PG8_STAGE(PG8_SA(1, 0), cA + kstep, voffA); PG8_STAGE(PG8_SB(1, 1), cB + hstep + kstep, voffB);
        PG8_WAIT_V(6); PG8_BAR;
    }
    for (;;) {
        const bool has_next = S.next(ui + 1, nxt);
        const char* nA = has_next ? (const char*)g.A + (size_t)nxt.pm * tstep : cA; const char* nB = has_next ? (const char*)g.Bt + (size_t)nxt.pn * tstep : cB;
        for (int t = 0; t < nt; t += 2) {
            const bool last = (t == nt - 2);
            const char* a1 = cA + (size_t)(t + 1) * kstep;
            const char* a2 = last ? nA : cA + (size_t)(t + 2) * kstep; const char* b2 = last ? nB : cB + (size_t)(t + 2) * kstep;
            const char* a3 = a2 + kstep; const char* b3 = b2 + kstep;
            if (last && has_next) S.a_ready(nxt);
            if constexpr (SP2) {
            PG8_LDB(B0, 0, 0); PG8_LDB(B1, 0, 1); PG8_SCHED; PG8_LDA(At, 0, 0); PG8_STAGE(PG8_SA(1, 1), a1 + hstep, voffA);
            PG8_WAIT_V(8); PG8_WAIT_L(0); PG8_BAR; PG8_MMA(0, 0, At, B0); PG8_MMA(0, 1, At, B1); PG8_BAR; PG8_SCHED;
            PG8_LDA(At, 0, 1); PG8_STAGE(PG8_SB(0, 0), b2, voffB); PG8_STAGE(PG8_SB(0, 1), b2 + hstep, voffB); PG8_STAGE(PG8_SA(0, 0), a2, voffA);
            PG8_WAIT_V(8); PG8_WAIT_L(0); PG8_BAR; PG8_MMA(1, 0, At, B0); PG8_MMA(1, 1, At, B1); PG8_BAR; PG8_SCHED;
            PG8_LDB(B0, 1, 0); PG8_LDB(B1, 1, 1); PG8_SCHED; PG8_LDA(At, 1, 0); PG8_STAGE(PG8_SA(0, 1), a2 + hstep, voffA);
            PG8_WAIT_V(8); PG8_WAIT_L(0); PG8_BAR; PG8_MMA(0, 0, At, B0); PG8_MMA(0, 1, At, B1); PG8_BAR; PG8_SCHED;
            PG8_LDA(At, 1, 1); PG8_STAGE(PG8_SB(1, 0), b3, voffB); PG8_STAGE(PG8_SB(1, 1), b3 + hstep, voffB); PG8_STAGE(PG8_SA(1, 0), a3, voffA);
            PG8_WAIT_V(8); PG8_WAIT_L(0); PG8_BAR; PG8_MMA(1, 0, At, B0); PG8_MMA(1, 1, At, B1); PG8_BAR; PG8_SCHED;
            } else {
            PG8_LDB(B0, 0, 0); PG8_SCHED; PG8_LDA(At, 0, 0); PG8_STAGE(PG8_SA(1, 1), a1 + hstep, voffA);
            PG8_WAIT_L(8); PG8_BAR; PG8_WAIT_L(0); PG8_MMA(0, 0, At, B0); PG8_BAR; PG8_SCHED;
            PG8_LDB(B1, 0, 1); PG8_STAGE(PG8_SB(0, 0), b2, voffB);
            PG8_BAR; PG8_WAIT_L(0); PG8_MMA(0, 1, At, B1); PG8_BAR;
            PG8_LDA(At, 0, 1); PG8_STAGE(PG8_SA(0, 0), a2, voffA);
            PG8_BAR; PG8_WAIT_L(0); PG8_MMA(1, 0, At, B0); PG8_BAR; PG8_SCHED;
            PG8_STAGE(PG8_SB(0, 1), b2 + hstep, voffB);
            PG8_WAIT_V(6); PG8_BAR; PG8_MMA(1, 1, At, B1); PG8_BAR;
            PG8_LDB(B0, 1, 0); PG8_SCHED; PG8_LDA(At, 1, 0); PG8_STAGE(PG8_SA(0, 1), a2 + hstep, voffA);
            PG8_WAIT_L(8); PG8_BAR; PG8_WAIT_L(0); PG8_MMA(0, 0, At, B0); PG8_BAR; PG8_SCHED;
            PG8_LDB(B1, 1, 1); PG8_STAGE(PG8_SB(1, 0), b3, voffB);
            PG8_BAR; PG8_WAIT_L(0); PG8_MMA(0, 1, At, B1); PG8_BAR;
            PG8_LDA(At, 1, 1); PG8_STAGE(PG8_SA(1, 0), a3, voffA);
            PG8_BAR; PG8_WAIT_L(0); PG8_MMA(1, 0, At, B0); PG8_BAR; PG8_SCHED;
            PG8_STAGE(PG8_SB(1, 1), b3 + hstep, voffB);
            PG8_WAIT_V(6); PG8_BAR; PG8_MMA(1, 1, At, B1); PG8_BAR;
            }
        }
        if constexpr (ALIGN_EPI) { if (wr == 0) PG8_BAR; }
        if constexpr (!Epi::AFTER_DRAIN) { E(acc, cur, wr, wc, fr, fq); S.done(cur); }
        if (!has_next) break;
#pragma unroll
        for (int a = 0; a < 2; ++a)
#pragma unroll
            for (int b = 0; b < 2; ++b)
#pragma unroll
                for (int m = 0; m < 4; ++m)
#pragma unroll
                    for (int n = 0; n < 2; ++n) acc[a][b][m][n] = (f32x4){0.f, 0.f, 0.f, 0.f};
        cur = nxt; cA = nA; cB = nB; ++ui;
        if constexpr (ALIGN_EPI) { if (wr == 1) PG8_BAR; }
    }
    PG8_WAIT_V(0);
    if constexpr (!ALIGN_EPI) { if (wr == 0) PG8_BAR; }
    PG8_BAR;
    if constexpr (Epi::AFTER_DRAIN) { E.fused(acc, cur, wr, wc, fr, fq, lds, wid, lane); S.done(cur); }
#undef PG8_SA
#undef PG8_SB
#undef PG8_STAGE
#undef PG8_LDA
#undef PG8_LDB
#undef PG8_MMA
#undef PG8_WAIT_V
#undef PG8_WAIT_L
#undef PG8_BAR
#undef PG8_SCHED
}
}
#ifndef MK_ONE_LAUNCH
#define MK_ONE_LAUNCH 1
#endif
constexpr int NWAVES = 8;
constexpr int DM = 1024, INW = 7168, BRW = 2048, MIXW = 1536, XW = 512;
constexpr int TOK = 49152, CH = 16384, NCH = 3;
constexpr int MEMROWS = 1280;
constexpr int NAH = 24, XH = 4;
constexpr int ZQ = 0, ZK = 1536, ZV = 3072, ZQM = 4608, ZG = 5120;
constexpr float RMS_EPS = 1e-6f;
constexpr size_t MiB = 1u << 20;
constexpr size_t WS_CTL = 0, CTL_ZERO_BYTES = 1 * MiB;
constexpr size_t WS_W1T = 2 * MiB;
constexpr size_t WS_W2T = 30 * MiB;
constexpr size_t WS_WKVT = 38 * MiB;
constexpr size_t WS_MEMN = 42 * MiB;
constexpr size_t WS_MKV = 47 * MiB;
constexpr size_t WS_HB = 52 * MiB;
constexpr size_t WS_Y = 148 * MiB;
constexpr size_t WS_Z = 212 * MiB;
constexpr size_t WS_KIMG = 436 * MiB;
constexpr size_t WS_VTIMG = 439 * MiB;
constexpr size_t WS_END = 442 * MiB;
constexpr int CW_BAR = 4096;
constexpr int RING_OFF = 0, RING_BYTES = 131072;
constexpr int LDSCTL_OFF = RING_BYTES, MISC_OFF = LDSCTL_OFF + 320;
constexpr int LDS_BYTES = 163840;
constexpr int PH_PREP = 0, PH_MKV = 1, PH_IMG = 2, PH_L0 = 3, PH_PER_LAYER = 10, NPHASE = 23;

#define GAS __attribute__((address_space(1)))
#define LAS __attribute__((address_space(3)))
typedef unsigned short bf16;
typedef unsigned v4u __attribute__((ext_vector_type(4)));
typedef float f32x4 __attribute__((ext_vector_type(4)));
typedef GAS unsigned gu32;
#define RLX_AGENT __ATOMIC_RELAXED, __HIP_MEMORY_SCOPE_AGENT
#define LDS_WAIT() asm volatile("s_waitcnt lgkmcnt(0)" ::: "memory")
__device__ __forceinline__ unsigned f2bf(float f) { unsigned u = __builtin_bit_cast(unsigned, f); return (u + 0x7fffu + ((u >> 16) & 1u)) >> 16; }
__device__ __forceinline__ unsigned pk2(float lo, float hi) { return f2bf(lo) | (f2bf(hi) << 16); }
__device__ __forceinline__ float bf2f(unsigned short b) { return __uint_as_float((unsigned)b << 16); }
__device__ __forceinline__ float bflo(unsigned w) { return __uint_as_float(w << 16); }
__device__ __forceinline__ float bfhi(unsigned w) { return __uint_as_float(w & 0xffff0000u); }
__device__ __forceinline__ float silu(float g) { return g / (1.0f + __expf(-g)); }
__device__ __forceinline__ float wave_sum(float v) {
#pragma unroll
    for (int o = 1; o < 64; o <<= 1) v += __shfl_xor(v, o);
    return v;
}
__device__ __forceinline__ float wave_max(float v) {
#pragma unroll
    for (int o = 1; o < 64; o <<= 1) v = fmaxf(v, __shfl_xor(v, o));
    return v;
}
template <int OFF> __device__ __forceinline__ unsigned long long karg64() {
    unsigned long long v; auto ka = __builtin_amdgcn_kernarg_segment_ptr();
    asm volatile("s_load_dwordx2 %0, %1, %2\n\ts_waitcnt lgkmcnt(0)" : "=s"(v) : "s"(ka), "i"(OFF) : "memory");
    return v;
}
#define XB_TMO      128
#define XB_XCNT(j)  (256  + 64 * (j))
#define XB_XSUB(j)  (1280 + 64 * (j))
#define XB_XGEN(j)  (2304 + 64 * (j))
#define XB_TOP      3328
#define XB_TOPGEN   3392
#define XCD_BAR_WORDS 3456
#define XB_SPIN_CAP (1u << 18)

__device__ __forceinline__ unsigned xb_ld(unsigned* p)              { return __hip_atomic_load(p, __ATOMIC_RELAXED, __HIP_MEMORY_SCOPE_AGENT); }
__device__ __forceinline__ unsigned xb_add(unsigned* p, unsigned v) { return __hip_atomic_fetch_add(p, v, __ATOMIC_RELAXED, __HIP_MEMORY_SCOPE_AGENT); }
__device__ __forceinline__ unsigned xb_xcc_id() { return (unsigned)__builtin_amdgcn_s_getreg((3 << 11) | 20) & 0xFu; }
#define XB_SPIN(cond, bar) do { unsigned _sp = 0; while (cond) { __builtin_amdgcn_s_sleep(1); \
    if ((++_sp & 255u) == 0u) { if (xb_ld(&(bar)[XB_TMO])) break; if (_sp > XB_SPIN_CAP) { atomicAdd(&(bar)[XB_TMO], 1u); break; } } } } while (0)

struct XcdBarrier {
    unsigned* bar; unsigned x;
    volatile LAS unsigned* st;
};

__device__ __forceinline__ XcdBarrier xcd_barrier_post(unsigned* bar, volatile LAS unsigned* st) {
    XcdBarrier b; b.bar = bar; b.x = xb_xcc_id(); b.st = st;
    if (threadIdx.x == 0) (void)xb_add(&bar[XB_XCNT(b.x)], 1u);
    return b;
}
__device__ __forceinline__ void xcd_barrier_complete(unsigned* bar, unsigned x, unsigned& nloc, unsigned& nx) {
    const unsigned G = gridDim.x * gridDim.y * gridDim.z;
    unsigned sum, cnt, mine, sp = 0u;
    for (;;) {
        sum = 0u; cnt = 0u; mine = 0u;
#pragma unroll
        for (unsigned j = 0; j < 16; ++j) { const unsigned c = xb_ld(&bar[XB_XCNT(j)]); sum += c; cnt += (c > 0u) ? 1u : 0u; mine = (j == x) ? c : mine; }
        if (sum == G) break;
        __builtin_amdgcn_s_sleep(1);
        if ((++sp & 255u) == 0u) { if (xb_ld(&bar[XB_TMO])) break; if (sp > XB_SPIN_CAP) { atomicAdd(&bar[XB_TMO], 1u); break; } }
    }
    nloc = mine > 0u ? mine : 1u; nx = cnt > 0u ? cnt : 1u;
}

__device__ __forceinline__ void xcd_barrier(const XcdBarrier& b) {
    asm volatile("s_waitcnt vmcnt(0)" ::: "memory");
    __syncthreads();
    if (threadIdx.x == 0) {
        unsigned* bar = b.bar;
        __builtin_amdgcn_s_waitcnt(0);
        unsigned nloc = b.st[0], nx = b.st[1];
        if (nloc == 0u) { xcd_barrier_complete(bar, b.x, nloc, nx); b.st[0] = nloc; b.st[1] = nx; }
        const unsigned old = xb_add(&bar[XB_XSUB(b.x)], 1u);
        const unsigned gen = old / nloc;
        if (old + 1u == (gen + 1u) * nloc) {
            __builtin_amdgcn_fence(__ATOMIC_RELEASE, "agent");
            asm volatile("s_waitcnt vmcnt(0)" ::: "memory");
            const unsigned og = xb_add(&bar[XB_TOP], 1u);
            const unsigned tg = og / nx;
            if (og + 1u == (tg + 1u) * nx) xb_add(&bar[XB_TOPGEN], 1u);
            else XB_SPIN(xb_ld(&bar[XB_TOPGEN]) == tg, bar);
            __builtin_amdgcn_fence(__ATOMIC_ACQUIRE, "agent");
            xb_add(&bar[XB_XGEN(b.x)], 1u);
            asm volatile("s_waitcnt vmcnt(0)" ::: "memory");
        } else {
            XB_SPIN(xb_ld(&bar[XB_XGEN(b.x)]) == gen, bar);
            __builtin_amdgcn_fence(__ATOMIC_ACQUIRE, "agent");
            asm volatile("s_waitcnt vmcnt(0)" ::: "memory");
        }
    }
    __syncthreads();
}
__device__ __forceinline__ void transpose_item(const float* W, int K, int N, bf16* WT, LAS float* scr, int item, int lane) {
    const int nblk = N / 32, kb = item / nblk, nb = item % nblk, k0 = 64 * kb, n0 = 32 * nb;
#pragma unroll 8
    for (int i = 0; i < 32; ++i) { const int kk = 2 * i + (lane >> 5); scr[kk * 33 + (lane & 31)] = W[(size_t)(k0 + kk) * N + n0 + (lane & 31)]; }
    LDS_WAIT(); asm volatile("" ::: "memory");
    const int c = lane & 7;
#pragma unroll
    for (int j = 0; j < 4; ++j) { const int n = (lane >> 3) + 8 * j; const LAS float* s = scr + (8 * c) * 33 + n;
        v4u o; o.x = pk2(s[0 * 33], s[1 * 33]); o.y = pk2(s[2 * 33], s[3 * 33]); o.z = pk2(s[4 * 33], s[5 * 33]); o.w = pk2(s[6 * 33], s[7 * 33]);
        *(GAS v4u*)(WT + (size_t)(n0 + n) * K + k0 + 8 * c) = o; }
    LDS_WAIT(); asm volatile("" ::: "memory");
}
__device__ __forceinline__ void rms_row_to_bf16(const float* xrow, const float* w, bf16* orow, int lane) {
    const GAS f32x4* xr = (const GAS f32x4*)xrow + lane; const GAS f32x4* wr = (const GAS f32x4*)w + lane;
    f32x4 v[4]; float s = 0.f;
#pragma unroll
    for (int j = 0; j < 4; ++j) { v[j] = xr[64 * j]; s += (v[j].x * v[j].x + v[j].y * v[j].y) + (v[j].z * v[j].z + v[j].w * v[j].w); }
    const float rstd = 1.f / sqrtf(wave_sum(s) * (1.f / DM) + RMS_EPS);
    GAS unsigned long long* o8 = (GAS unsigned long long*)orow + lane;
#pragma unroll
    for (int j = 0; j < 4; ++j) { const f32x4 ww = wr[64 * j];
        o8[64 * j] = (unsigned long long)pk2(v[j].x * rstd * ww.x, v[j].y * rstd * ww.y) | ((unsigned long long)pk2(v[j].z * rstd * ww.z, v[j].w * rstd * ww.w) << 32); }
}
__device__ __forceinline__ void rms_row_to_f32(const float* xrow, const float* w, float* orow, int lane) {
    const GAS f32x4* xr = (const GAS f32x4*)xrow + lane; const GAS f32x4* wr = (const GAS f32x4*)w + lane;
    f32x4 v[4]; float s = 0.f;
#pragma unroll
    for (int j = 0; j < 4; ++j) { v[j] = xr[64 * j]; s += (v[j].x * v[j].x + v[j].y * v[j].y) + (v[j].z * v[j].z + v[j].w * v[j].w); }
    const float rstd = 1.f / sqrtf(wave_sum(s) * (1.f / DM) + RMS_EPS);
    GAS f32x4* o = (GAS f32x4*)orow + lane;
#pragma unroll
    for (int j = 0; j < 4; ++j) { const f32x4 ww = wr[64 * j]; o[64 * j] = (v[j] * rstd) * ww; }
}

struct Ptrs {
    const float *xp, *xs, *memp, *mems, *norm_w, *w_in, *w_out, *mem_norm_w, *w_mem_kv, *conv_w, *conv_b, *na_rpb, *final_norm_w;
    float* out;
    bf16 *W1T, *W2T, *WKVT, *MEMN, *MKV, *HB, *Y, *Z;
    unsigned char *KIMG, *VTIMG;
};

__device__ __forceinline__ void phase_prep(const Ptrs& P, LAS unsigned char* lds, int gw, int NGW, int wave, int lane) {
    LAS float* scr = (LAS float*)(lds + RING_OFF + wave * 16384);
    constexpr int I_W1 = (DM / 64) * (INW / 32), I_W2 = (BRW / 64) * (DM / 32), I_KV = (DM / 64) * (DM / 32);
    constexpr int NITEMS = 2 * (I_W1 + I_W2 + I_KV);
    for (int it = gw; it < NITEMS; it += NGW) {
        int r = it;
        if (r < 2 * I_W1) { const int l = r / I_W1; transpose_item(P.w_in + (size_t)l * DM * INW, DM, INW, P.W1T + (size_t)l * INW * DM, scr, r % I_W1, lane); continue; } r -= 2 * I_W1;
        if (r < 2 * I_W2) { const int l = r / I_W2; transpose_item(P.w_out + (size_t)l * BRW * DM, BRW, DM, P.W2T + (size_t)l * DM * BRW, scr, r % I_W2, lane); continue; } r -= 2 * I_W2;
        { const int l = r / I_KV; transpose_item(P.w_mem_kv + (size_t)l * DM * DM, DM, DM, P.WKVT + (size_t)l * DM * DM, scr, r % I_KV, lane); }
    }
    for (int m = gw; m < 2 * MEMROWS; m += NGW) { const int l = m / MEMROWS, r = m % MEMROWS;
        const float* src = (r < 1024) ? P.memp + (size_t)r * DM : P.mems + (size_t)(r - 1024) * DM;
        rms_row_to_bf16(src, P.mem_norm_w + l * DM, P.MEMN + (size_t)m * DM, lane); }
    for (int m = gw; m < TOK; m += NGW) { const float* src = (m < 32768) ? P.xp + (size_t)m * DM : P.xs + (size_t)(m - 32768) * DM;
        rms_row_to_bf16(src, P.norm_w, P.HB + (size_t)m * DM, lane); }
}

__device__ __forceinline__ void phase_conv(const Ptrs& P, int chunk, int gt, int NGT) {
    const int seqlen = (chunk == 2) ? 16384 : 8192;
    const bf16* z = P.Z; bf16* y = P.Y;
    for (int it = gt; it < CH * (MIXW / 8); it += NGT) {
        const int tl = it / (MIXW / 8), cg = it % (MIXW / 8), ch = cg * 8;
        const int ts = tl % seqlen; const bool hp = ts > 0, hn = ts < seqlen - 1;
        const bf16* zr = z + (size_t)tl * INW + ch;
        const v4u p0 = *(const GAS v4u*)(zr + ZQ), p1 = *(const GAS v4u*)(zr + ZK), p2 = *(const GAS v4u*)(zr + ZV), gg = *(const GAS v4u*)(zr + ZG);
        v4u a1 = (v4u){0, 0, 0, 0}, a2 = a1, b1 = a1, b2 = a1;
        if (hp) { a1 = *(const GAS v4u*)(zr - INW + ZK); a2 = *(const GAS v4u*)(zr - INW + ZV); }
        if (hn) { b1 = *(const GAS v4u*)(zr + INW + ZK); b2 = *(const GAS v4u*)(zr + INW + ZV); }
        float cw0[8], cw1[8], cw2[8], cb[8];
#pragma unroll
        for (int j = 0; j < 8; ++j) { cw0[j] = P.conv_w[ch + j]; cw1[j] = P.conv_w[MIXW + ch + j]; cw2[j] = P.conv_w[2 * MIXW + ch + j]; cb[j] = P.conv_b[ch + j]; }
        v4u o;
#pragma unroll
        for (int w = 0; w < 4; ++w) {
            float r[2];
#pragma unroll
            for (int e = 0; e < 2; ++e) {
                const int j = 2 * w + e;
                const float vp = e ? bfhi(a1[w]) * bfhi(a2[w]) : bflo(a1[w]) * bflo(a2[w]);
                const float vc = e ? bfhi(p1[w]) * bfhi(p2[w]) : bflo(p1[w]) * bflo(p2[w]);
                const float vn = e ? bfhi(b1[w]) * bfhi(b2[w]) : bflo(b1[w]) * bflo(b2[w]);
                const float conv = vp * cw0[j] + vc * cw1[j] + vn * cw2[j] + cb[j];
                const float b = e ? bfhi(p0[w]) : bflo(p0[w]);
                const float g = e ? bfhi(gg[w]) : bflo(gg[w]);
                r[e] = b * conv * silu(g);
            }
            o[w] = pk2(r[0], r[1]);
        }
        *(GAS v4u*)(y + (size_t)tl * BRW + ch) = o;
    }
}

__device__ __forceinline__ void phase_na_naive(const Ptrs& P, int chunk, int gw, int NGW, int lane) {
    const int seqlen = (chunk == 2) ? 16384 : 8192; const int rows = seqlen / 64;
    const bf16* z = P.Z; bf16* y = P.Y; const float* rpb = P.na_rpb;
    for (int task = gw; task < CH * NAH; task += NGW) {
        const int tl = task / NAH, h = task % NAH;
        const int ss = (tl / seqlen) * seqlen, ts = tl - ss, r = ts >> 6, c = ts & 63;
        int r0 = r - 4; r0 = r0 < 0 ? 0 : (r0 > rows - 8 ? rows - 8 : r0);
        int c0 = c - 8; c0 = c0 < 0 ? 0 : (c0 > 48 ? 48 : c0);
        v4u qv[8];
        { const GAS v4u* qp = (const GAS v4u*)(z + (size_t)tl * INW + ZQ + h * 64);
#pragma unroll
          for (int i = 0; i < 8; ++i) qv[i] = qp[i]; }
        float lg[2];
#pragma unroll
        for (int u = 0; u < 2; ++u) {
            const int kk = lane + 64 * u, a = kk >> 4, j = kk & 15;
            const int kt = ss + (r0 + a) * 64 + c0 + j;
            const GAS v4u* kp = (const GAS v4u*)(z + (size_t)kt * INW + ZK + h * 64);
            float dot = 0.f;
#pragma unroll
            for (int i = 0; i < 8; ++i) { const v4u kv = kp[i];
#pragma unroll
                for (int w = 0; w < 4; ++w) dot += bflo(qv[i][w]) * bflo(kv[w]) + bfhi(qv[i][w]) * bfhi(kv[w]); }
            lg[u] = dot * 0.125f + rpb[(h * 15 + (r0 + a - r + 7)) * 31 + (c0 + j - c + 15)];
        }
        const float mx = wave_max(fmaxf(lg[0], lg[1]));
        float pe[2]; pe[0] = __expf(lg[0] - mx); pe[1] = __expf(lg[1] - mx);
        const float inv = 1.f / wave_sum(pe[0] + pe[1]);
        pe[0] *= inv; pe[1] *= inv;
        float o = 0.f;
#pragma unroll
        for (int u = 0; u < 2; ++u)
            for (int kl = 0; kl < 64; ++kl) {
                const float p = __shfl(pe[u], kl);
                const int kk = kl + 64 * u, a = kk >> 4, j = kk & 15;
                const int kt = ss + (r0 + a) * 64 + c0 + j;
                o += p * bf2f(z[(size_t)kt * INW + ZV + h * 64 + lane]);
            }
        const float g = bf2f(z[(size_t)tl * INW + ZG + h * 64 + lane]);
        y[(size_t)tl * BRW + h * 64 + lane] = (bf16)f2bf(o * silu(g));
    }
}

__device__ __forceinline__ void phase_xattn_naive(const Ptrs& P, int layer, int chunk, int gw, int NGW, int lane) {
    const bf16* z = P.Z; bf16* y = P.Y;
    for (int task = gw; task < CH * XH; task += NGW) {
        const int tl = task / XH, h = task % XH;
        const int g = chunk * CH + tl, s = (g < 32768) ? (g >> 13) : 4;
        const bf16* kb = P.MKV + ((size_t)layer * MEMROWS + s * 256) * DM + h * 128;
        const bf16* vb = kb + 512;
        v4u qv[16];
        { const GAS v4u* qp = (const GAS v4u*)(z + (size_t)tl * INW + ZQM + h * 128);
#pragma unroll
          for (int i = 0; i < 16; ++i) qv[i] = qp[i]; }
        float lg[4];
#pragma unroll
        for (int u = 0; u < 4; ++u) {
            const int key = lane + 64 * u;
            const GAS v4u* kp = (const GAS v4u*)(kb + (size_t)key * DM);
            float dot = 0.f;
#pragma unroll
            for (int i = 0; i < 16; ++i) { const v4u kv = kp[i];
#pragma unroll
                for (int w = 0; w < 4; ++w) dot += bflo(qv[i][w]) * bflo(kv[w]) + bfhi(qv[i][w]) * bfhi(kv[w]); }
            lg[u] = dot * 0.08838834764831845f;
        }
        const float mx = wave_max(fmaxf(fmaxf(lg[0], lg[1]), fmaxf(lg[2], lg[3])));
        float pe[4]; float sm = 0.f;
#pragma unroll
        for (int u = 0; u < 4; ++u) { pe[u] = __expf(lg[u] - mx); sm += pe[u]; }
        const float inv = 1.f / wave_sum(sm);
        float o0 = 0.f, o1 = 0.f;
#pragma unroll
        for (int u = 0; u < 4; ++u)
            for (int kl = 0; kl < 64; ++kl) {
                const float p = __shfl(pe[u], kl) * inv;
                const unsigned vv = *(const GAS unsigned*)(vb + (size_t)(kl + 64 * u) * DM + 2 * lane);
                o0 += p * bflo(vv); o1 += p * bfhi(vv);
            }
        const unsigned gg = *(const GAS unsigned*)(z + (size_t)tl * INW + ZG + MIXW + h * 128 + 2 * lane);
        *(GAS unsigned*)(y + (size_t)tl * BRW + MIXW + h * 128 + 2 * lane) = pk2(o0 * silu(bflo(gg)), o1 * silu(bfhi(gg)));
    }
}
namespace xa {
typedef short bf16x8 __attribute__((ext_vector_type(8)));
typedef float f32x16 __attribute__((ext_vector_type(16)));
typedef float f32x2_t __attribute__((ext_vector_type(2))); typedef __bf16 bf16x2_t __attribute__((ext_vector_type(2)));
typedef unsigned u32x4 __attribute__((ext_vector_type(4)));
__device__ __forceinline__ int crow(int r, int h) { return (r & 3) + 8 * (r >> 2) + 4 * h; }
__device__ __forceinline__ unsigned cvtpk(float lo, float hi) { f32x2_t v = {lo, hi}; bf16x2_t b = __builtin_convertvector(v, bf16x2_t); return __builtin_bit_cast(unsigned, b); }
__device__ __forceinline__ int pos2key16(int p) { return 8 * ((p & 7) >> 2) + 4 * (p >> 3) + (p & 3); }
constexpr int XSCR_OFF = RING_BYTES + 1024;
constexpr float C2 = 0.08838834764831845f * 1.4426950408889634f;

__device__ __forceinline__ void xattn_unit(LAS unsigned char* lds, const bf16* z, bf16* y, int row0, int h, const unsigned char* kimg, const unsigned char* vtimg, int tid) {
    const int lane = tid & 63, wid = __builtin_amdgcn_readfirstlane(tid >> 6), r32 = lane & 31, hh = lane >> 5;
    { const unsigned char* src = (wid < 4 ? kimg : vtimg - 65536) + (size_t)wid * 16384 + lane * 16;
#pragma unroll
      for (int i = 0; i < 16; ++i) __builtin_amdgcn_global_load_lds((const GAS unsigned*)(src + i * 1024), (LAS unsigned*)(lds + wid * 16384 + i * 1024), 16, 0, 0); }
    bf16x8 qf[8];
    { const bf16* qp = z + (size_t)(row0 + wid * 32 + r32) * INW + ZQM + h * 128 + hh * 8;
#pragma unroll
      for (int ks = 0; ks < 8; ++ks) qf[ks] = *(const GAS bf16x8*)(qp + ks * 16); }
    asm volatile("s_waitcnt vmcnt(0)" ::: "memory");
    __syncthreads();
    f32x16 s[8];
#pragma unroll
    for (int kb = 0; kb < 8; ++kb) {
        const int key = kb * 32 + r32;
        f32x16 acc;
#pragma unroll
        for (int i = 0; i < 16; ++i) acc[i] = 0.f;
#pragma unroll
        for (int ks = 0; ks < 8; ++ks) {
            const bf16x8 a = *(const LAS bf16x8*)(lds + key * 256 + (((2 * ks + hh) ^ (key & 15)) << 4));
            acc = __builtin_amdgcn_mfma_f32_32x32x16_bf16(a, qf[ks], acc, 0, 0, 0);
        }
        s[kb] = acc;
    }
    float m = s[0][0];
#pragma unroll
    for (int kb = 0; kb < 8; ++kb)
#pragma unroll
        for (int r = 0; r < 16; ++r) m = fmaxf(m, s[kb][r]);
    m = fmaxf(m, __shfl_xor(m, 32));
    const float mc = m * C2;
    float lsum = 0.f;
#pragma unroll
    for (int kb = 0; kb < 8; ++kb)
#pragma unroll
        for (int r = 0; r < 16; ++r) { const float p = __builtin_amdgcn_exp2f(s[kb][r] * C2 - mc); s[kb][r] = p; lsum += p; }
    lsum += __shfl_xor(lsum, 32);
    __syncthreads();
    f32x16 o[4];
#pragma unroll
    for (int db = 0; db < 4; ++db)
#pragma unroll
        for (int i = 0; i < 16; ++i) o[db][i] = 0.f;
#pragma unroll
    for (int kb = 0; kb < 8; ++kb)
#pragma unroll
        for (int st = 0; st < 2; ++st) {
            u32x4 pw;
#pragma unroll
            for (int j = 0; j < 4; ++j) pw[j] = cvtpk(s[kb][8 * st + 2 * j], s[kb][8 * st + 2 * j + 1]);
            const bf16x8 pa = __builtin_bit_cast(bf16x8, pw);
            const int c = 4 * kb + 2 * st + hh;
#pragma unroll
            for (int db = 0; db < 4; ++db) {
                const int d = db * 32 + r32;
                const bf16x8 b = *(const LAS bf16x8*)(lds + 65536 + d * 512 + ((((c & 15) ^ (d & 15)) | (c & 16)) << 4));
                o[db] = __builtin_amdgcn_mfma_f32_32x32x16_bf16(pa, b, o[db], 0, 0, 0);
            }
        }
    LAS float* lsc = (LAS float*)(lds + XSCR_OFF + wid * 128);
    if (hh == 0) lsc[r32] = lsum;
    asm volatile("s_waitcnt lgkmcnt(0)" ::: "memory");
    LAS bf16* stg = (LAS bf16*)(lds + wid * 8192);
#pragma unroll
    for (int r = 0; r < 16; ++r) {
        const int q = crow(r, hh); const float rl = 1.0f / lsc[q];
#pragma unroll
        for (int db = 0; db < 4; ++db) stg[q * 128 + db * 32 + r32] = (bf16)f2bf(o[db][r] * rl);
    }
    asm volatile("s_waitcnt lgkmcnt(0)" ::: "memory");
#pragma unroll
    for (int i = 0; i < 8; ++i) {
        const int idx = i * 64 + lane, row = idx >> 4, ch = idx & 15;
        const u32x4 ov = *(const LAS u32x4*)(stg + row * 128 + ch * 8);
        const size_t grow = (size_t)(row0 + wid * 32 + row);
        const u32x4 gv = *(const GAS u32x4*)(z + grow * INW + ZG + MIXW + h * 128 + ch * 8);
        u32x4 w;
#pragma unroll
        for (int j = 0; j < 4; ++j) w[j] = pk2(bflo(ov[j]) * silu(bflo(gv[j])), bfhi(ov[j]) * silu(bfhi(gv[j])));
        *(GAS u32x4*)(y + grow * BRW + MIXW + h * 128 + ch * 8) = w;
    }
    __syncthreads();
}
}

__device__ __forceinline__ void phase_img(const bf16* MKV, unsigned char* KIMG, unsigned char* VTIMG, int gt, int NGT) {
    for (int it = gt; it < 40 * 4096; it += NGT) {
        const int img = it >> 12, key = (it >> 4) & 255, c = it & 15, ls = img >> 2, h = img & 3;
        const v4u v = *(const GAS v4u*)(MKV + ((size_t)ls * 256 + key) * DM + h * 128 + c * 8);
        *(GAS v4u*)(KIMG + (size_t)img * 65536 + key * 256 + ((c ^ (key & 15)) << 4)) = v;
    }
    for (int it = gt; it < 40 * 4096; it += NGT) {
        const int img = it >> 12, d = (it >> 5) & 127, c = it & 31, ls = img >> 2, h = img & 3;
        const bf16* vsrc = MKV + (size_t)ls * 256 * DM + 512 + h * 128 + d;
        unsigned short e[8];
#pragma unroll
        for (int j = 0; j < 8; ++j) { const int p = c * 8 + j, key = (p & ~15) + xa::pos2key16(p & 15); e[j] = vsrc[(size_t)key * DM]; }
        v4u v; v.x = e[0] | ((unsigned)e[1] << 16); v.y = e[2] | ((unsigned)e[3] << 16); v.z = e[4] | ((unsigned)e[5] << 16); v.w = e[6] | ((unsigned)e[7] << 16);
        *(GAS v4u*)(VTIMG + (size_t)img * 65536 + d * 512 + ((((c & 15) ^ (d & 15)) | (c & 16)) << 4)) = v;
    }
}
namespace na {
typedef short bf16x8 __attribute__((ext_vector_type(8)));
typedef short s16x4 __attribute__((ext_vector_type(4)));
typedef float f32x4 __attribute__((ext_vector_type(4)));
typedef unsigned u32x4 __attribute__((ext_vector_type(4)));
constexpr int V_OFF = 61440, RPB_OFF = RING_BYTES + 2048, STG_OFF = RING_BYTES + 4096;
constexpr float LOG2E = 1.4426950408889634f, QS = 0.125f * LOG2E;
__device__ __forceinline__ int clampi(int v, int lo, int hi) { return v < lo ? lo : (v > hi ? hi : v); }
__device__ __forceinline__ s16x4 vtr(unsigned addr) { return __builtin_bit_cast(s16x4, __builtin_amdgcn_ds_read_tr16_b64_v4i16((LAS s16x4*)addr)); }

__device__ __forceinline__ void na_unit(LAS unsigned char* lds, const bf16* z, bf16* y, const float* rpb_h, int seqstart, int rows, int band, int cb, int h, int tid) {
    const int lane = tid & 63, wid = __builtin_amdgcn_readfirstlane(tid >> 6), l16 = lane & 15, g = lane >> 4;
    const int r = band * 8 + wid;
    const int lo = clampi(band * 8 - 4, 0, rows - 15), r0 = clampi(r - 4, 0, rows - 8), kstart = clampi(16 * cb - 8, 0, 32);
    if (tid < 465) ((LAS float*)(lds + RPB_OFF))[tid] = rpb_h[tid] * LOG2E;
    { const int half = wid >> 2, key8 = lane >> 3, cp = lane & 7;
      const bf16* zb = z + (size_t)(seqstart + lo * 64 + kstart) * INW + (half ? ZV : ZK) + h * 64;
#pragma unroll
      for (int j = 0; j < 15; ++j) {
          const int pp = (wid & 3) * 15 + j, a15 = pp >> 2, key = (pp & 3) * 8 + key8, sw = key >> 1;
          const int c = half ? ((((cp >> 1) ^ (sw & 3)) << 1) | (cp & 1)) : (cp ^ (sw & 7));
          __builtin_amdgcn_global_load_lds((const GAS unsigned*)(zb + (size_t)(a15 * 64 + key) * INW + c * 8), (LAS unsigned*)(lds + half * V_OFF + pp * 1024), 16, 0, 0);
      } }
    const size_t qtok = (size_t)(seqstart + r * 64 + cb * 16 + l16);
    const bf16x8 qf0 = *(const GAS bf16x8*)(z + qtok * INW + ZQ + h * 64 + g * 8), qf1 = *(const GAS bf16x8*)(z + qtok * INW + ZQ + h * 64 + 32 + g * 8);
    const int qcol = cb * 16 + l16, cs = clampi(qcol - 8, 0, 48), dyb = r0 - r + 7;
    int dxo[8]; bool vld[8];
#pragma unroll
    for (int e = 0; e < 8; ++e) { const int kcol = kstart + 16 * (e >> 2) + 4 * g + (e & 3); vld[e] = (kcol >= cs) && (kcol < cs + 16); dxo[e] = clampi(kcol - qcol + 15, 0, 30); }
    asm volatile("s_waitcnt vmcnt(0)" ::: "memory");
    __syncthreads();
    const int slot0 = r0 - lo;
    f32x4 s[8][2];
#pragma unroll
    for (int a = 0; a < 8; ++a)
#pragma unroll
        for (int cbk = 0; cbk < 2; ++cbk) {
            const int key = 16 * cbk + l16, sw = (key >> 1) & 7;
            LAS unsigned char* kb = lds + (slot0 + a) * 4096 + key * 128;
            const bf16x8 a0 = *(const LAS bf16x8*)(kb + ((g ^ sw) << 4)), a1 = *(const LAS bf16x8*)(kb + (((4 + g) ^ sw) << 4));
            f32x4 acc = (f32x4){0.f, 0.f, 0.f, 0.f};
            acc = __builtin_amdgcn_mfma_f32_16x16x32_bf16(a0, qf0, acc, 0, 0, 0);
            acc = __builtin_amdgcn_mfma_f32_16x16x32_bf16(a1, qf1, acc, 0, 0, 0);
            s[a][cbk] = acc;
        }
    const LAS float* rp = (const LAS float*)(lds + RPB_OFF);
    float m = -INFINITY;
#pragma unroll
    for (int a = 0; a < 8; ++a)
#pragma unroll
        for (int e = 0; e < 8; ++e) {
            float t = s[a][e >> 2][e & 3] * QS + rp[(a + dyb) * 31 + dxo[e]];
            t = vld[e] ? t : -INFINITY;
            s[a][e >> 2][e & 3] = t; m = fmaxf(m, t);
        }
    m = fmaxf(m, __shfl_xor(m, 16)); m = fmaxf(m, __shfl_xor(m, 32));
    float lsum = 0.f;
#pragma unroll
    for (int a = 0; a < 8; ++a)
#pragma unroll
        for (int e = 0; e < 8; ++e) { const float p = __builtin_amdgcn_exp2f(s[a][e >> 2][e & 3] - m); s[a][e >> 2][e & 3] = p; lsum += p; }
    lsum += __shfl_xor(lsum, 16); lsum += __shfl_xor(lsum, 32);
    f32x4 o[4];
#pragma unroll
    for (int db = 0; db < 4; ++db) o[db] = (f32x4){0.f, 0.f, 0.f, 0.f};
    const int qq = l16 >> 2, pq = l16 & 3, klo = 4 * g + qq;
    const unsigned vlane = (unsigned)(uintptr_t)(lds + V_OFF) + klo * 128 + 8 * pq;
    const int vsw = (klo >> 1) & 3;
#pragma unroll
    for (int a = 0; a < 8; ++a) {
        u32x4 pw; pw[0] = xa::cvtpk(s[a][0][0], s[a][0][1]); pw[1] = xa::cvtpk(s[a][0][2], s[a][0][3]); pw[2] = xa::cvtpk(s[a][1][0], s[a][1][1]); pw[3] = xa::cvtpk(s[a][1][2], s[a][1][3]);
        const bf16x8 pa = __builtin_bit_cast(bf16x8, pw);
        const unsigned vb = vlane + (slot0 + a) * 4096;
#pragma unroll
        for (int db = 0; db < 4; ++db) {
            const s16x4 vl = vtr(vb + ((db ^ vsw) << 5)), vh = vtr(vb + 2048 + ((db ^ vsw) << 5));
            const bf16x8 b = (bf16x8){vl[0], vl[1], vl[2], vl[3], vh[0], vh[1], vh[2], vh[3]};
            o[db] = __builtin_amdgcn_mfma_f32_16x16x32_bf16(pa, b, o[db], 0, 0, 0);
        }
    }
    float rl[4];
#pragma unroll
    for (int i = 0; i < 4; ++i) rl[i] = 1.0f / __shfl(lsum, 4 * g + i);
    LAS bf16* stg = (LAS bf16*)(lds + STG_OFF + wid * 2048);
#pragma unroll
    for (int db = 0; db < 4; ++db)
#pragma unroll
        for (int i = 0; i < 4; ++i) stg[(4 * g + i) * 64 + 16 * db + l16] = (bf16)f2bf(o[db][i] * rl[i]);
    asm volatile("s_waitcnt lgkmcnt(0)" ::: "memory");
#pragma unroll
    for (int i2 = 0; i2 < 2; ++i2) {
        const int idx = i2 * 64 + lane, q = idx >> 3, ch = idx & 7;
        const u32x4 ov = *(const LAS u32x4*)(stg + q * 64 + ch * 8);
        const size_t tok = (size_t)(seqstart + r * 64 + cb * 16 + q);
        const u32x4 gv = *(const GAS u32x4*)(z + tok * INW + ZG + h * 64 + ch * 8);
        u32x4 w;
#pragma unroll
        for (int j = 0; j < 4; ++j) w[j] = pk2(bflo(ov[j]) * silu(bflo(gv[j])), bfhi(ov[j]) * silu(bfhi(gv[j])));
        *(GAS u32x4*)(y + tok * BRW + h * 64 + ch * 8) = w;
    }
    __syncthreads();
}
}
struct Args { const float* in[13]; float* out; unsigned char* ws; int ph_lo, ph_hi; };
__global__ void __launch_bounds__(NWAVES * 64, 2) fwd_kernel(Args args) {
    extern __shared__ __attribute__((aligned(16))) unsigned char lds_raw[];
    LAS unsigned char* lds = (LAS unsigned char*)lds_raw;
    volatile LAS unsigned* MISC = (volatile LAS unsigned*)(lds + MISC_OFF);
#define KARG(off) karg64<(off)>()
#define LOAD_PTRS() Ptrs P; do { unsigned char* ws_ = (unsigned char*)(GAS unsigned char*)KARG(112); \
    P.xp = (const float*)(const GAS float*)KARG(0); P.xs = (const float*)(const GAS float*)KARG(8); P.memp = (const float*)(const GAS float*)KARG(16); P.mems = (const float*)(const GAS float*)KARG(24); P.norm_w = (const float*)(const GAS float*)KARG(32); \
    P.w_in = (const float*)(const GAS float*)KARG(40); P.w_out = (const float*)(const GAS float*)KARG(48); P.mem_norm_w = (const float*)(const GAS float*)KARG(56); P.w_mem_kv = (const float*)(const GAS float*)KARG(64); P.conv_w = (const float*)(const GAS float*)KARG(72); \
    P.conv_b = (const float*)(const GAS float*)KARG(80); P.na_rpb = (const float*)(const GAS float*)KARG(88); P.final_norm_w = (const float*)(const GAS float*)KARG(96); P.out = (float*)(GAS float*)KARG(104); \
    P.W1T = (bf16*)(ws_ + WS_W1T); P.W2T = (bf16*)(ws_ + WS_W2T); P.WKVT = (bf16*)(ws_ + WS_WKVT); P.MEMN = (bf16*)(ws_ + WS_MEMN); P.MKV = (bf16*)(ws_ + WS_MKV); \
    P.HB = (bf16*)(ws_ + WS_HB); P.Y = (bf16*)(ws_ + WS_Y); P.Z = (bf16*)(ws_ + WS_Z); P.KIMG = ws_ + WS_KIMG; P.VTIMG = ws_ + WS_VTIMG; } while (0)
    for (int u = threadIdx.x; u < (LDS_BYTES - LDSCTL_OFF) / 4; u += NWAVES * 64) ((LAS unsigned*)(lds + LDSCTL_OFF))[u] = 0u;
    __syncthreads();
    const int lo = args.ph_lo, hi = args.ph_hi;
    if (hi - lo > 1) (void)xcd_barrier_post((unsigned*)((gu32*)((GAS unsigned char*)KARG(112) + WS_CTL) + CW_BAR), MISC + 8);

    for (int ph = lo; ph < hi; ++ph) {
        int tid = threadIdx.x; asm volatile("" : "+v"(tid));
        int bx = blockIdx.x; asm volatile("" : "+s"(bx));
        int G = gridDim.x; asm volatile("" : "+s"(G));
        const int lane = tid & 63, wave = __builtin_amdgcn_readfirstlane(tid >> 6);
        const int vcu = (G % 8 == 0) ? (bx % 8) * (G / 8) + bx / 8 : bx;
        const int gw = vcu * NWAVES + wave, NGW = G * NWAVES;
        const int gt = vcu * (NWAVES * 64) + tid, NGT = G * NWAVES * 64;
        LOAD_PTRS();
        if (ph == PH_PREP) {
            phase_prep(P, lds, gw, NGW, wave, lane);
        } else if (ph == PH_MKV) {
            for (int l = 0; l < 2; ++l) {
                pg8::Gemm g{P.MEMN + (size_t)l * MEMROWS * DM, P.WKVT + (size_t)l * DM * DM, MEMROWS, DM, DM};
                pg8::StaticOrder S; S.init(MEMROWS, DM, G, (bx + 128 * l) % G);
                pg8::EpiBf16<0> E{P.MKV + (size_t)l * MEMROWS * DM, DM, nullptr, 0, 0, 1.f};
                pg8::gemm_phase<pg8::EpiBf16<0>, pg8::StaticOrder, true, true>(lds + RING_OFF, g, S, E, tid);
            }
        } else if (ph == PH_IMG) {
            phase_img(P.MKV, P.KIMG, P.VTIMG, gt, NGT);
        } else {
            const int q = ph - PH_L0, layer = q / PH_PER_LAYER, r = q % PH_PER_LAYER;
            if (r == 9) {
                if (layer == 0) { for (int m = gw; m < TOK; m += NGW) rms_row_to_bf16(P.out + (size_t)m * DM, P.norm_w + DM, P.HB + (size_t)m * DM, lane); }
                else { for (int m = gw; m < TOK; m += NGW) rms_row_to_f32(P.out + (size_t)m * DM, P.final_norm_w, P.out + (size_t)m * DM, lane); }
            } else {
                const int chunk = r / 3, kind = r % 3;
                if (kind == 0) {
                    pg8::Gemm g{P.HB + (size_t)chunk * CH * DM, P.W1T + (size_t)layer * INW * DM, CH, INW, DM};
                    pg8::StaticOrder S; S.init(CH, INW, G, bx);
                    pg8::EpiBf16<0> E{P.Z, INW, nullptr, 0, 0, 1.f};
                    pg8::gemm_phase<pg8::EpiBf16<0>, pg8::StaticOrder, true, true>(lds + RING_OFF, g, S, E, tid);
                } else if (kind == 1) {
                    if (layer == 0) phase_conv(P, chunk, gt, NGT);
                    else {
                        const int seqlen = (chunk == 2) ? 16384 : 8192, rows = seqlen / 64, bps = rows / 8;
                        for (int u = vcu; u < 32 * NAH * 4; u += G) {
                            const int cb = u & 3, h = (u >> 2) % NAH, b32 = (u >> 2) / NAH;
                            na::na_unit(lds, P.Z, P.Y, P.na_rpb + h * 465, (b32 / bps) * seqlen, rows, b32 % bps, cb, h, tid);
                        }
                    }
                    for (int u = vcu; u < (CH / 256) * XH; u += G) {
                        const int pm = u >> 2, h = u & 3, grow = chunk * CH + pm * 256, seq = (grow < 32768) ? (grow >> 13) : 4, img = (layer * 5 + seq) * 4 + h;
                        xa::xattn_unit(lds, P.Z, P.Y, pm * 256, h, P.KIMG + (size_t)img * 65536, P.VTIMG + (size_t)img * 65536, tid);
                    }
                } else {
                    const float* base = (layer == 0) ? ((chunk < 2) ? P.xp + (size_t)chunk * CH * DM : P.xs) : P.out + (size_t)chunk * CH * DM;
                    pg8::Gemm g{P.Y, P.W2T + (size_t)layer * DM * BRW, CH, DM, BRW};
                    pg8::StaticOrder S; S.init(CH, DM, G, bx);
                    pg8::EpiResF32 E{base, P.out + (size_t)chunk * CH * DM, DM};
                    pg8::gemm_phase<pg8::EpiResF32, pg8::StaticOrder, true, true>(lds + RING_OFF, g, S, E, tid);
                }
            }
        }
        if (ph + 1 < hi) { XcdBarrier bar; bar.bar = (unsigned*)((gu32*)((GAS unsigned char*)KARG(112) + WS_CTL) + CW_BAR); bar.x = xb_xcc_id(); bar.st = MISC + 8; xcd_barrier(bar); }
    }
}

extern "C" void kernel_launch(void* const* d_in, const int* in_sizes, int n_in, void* d_out, int out_size, void* d_ws, size_t ws_size, hipStream_t stream) {
    static int grid = 0;
    if (grid == 0) {
        if (n_in != 13 || out_size != TOK * DM || ws_size < WS_END) { fprintf(stderr, "kernel_launch: unexpected shapes (n_in %d out %d ws %zu)\n", n_in, out_size, ws_size); grid = -1; return; }
        int dev = 0, cus = 0, per_cu = 0;
        if (hipGetDevice(&dev) != hipSuccess || hipDeviceGetAttribute(&cus, hipDeviceAttributeMultiprocessorCount, dev) != hipSuccess) { grid = -1; return; }
        if (hipFuncSetAttribute((const void*)fwd_kernel, hipFuncAttributeMaxDynamicSharedMemorySize, LDS_BYTES) != hipSuccess) { fprintf(stderr, "kernel_launch: hipFuncSetAttribute failed\n"); grid = -1; return; }
        if (hipOccupancyMaxActiveBlocksPerMultiprocessor(&per_cu, (const void*)fwd_kernel, NWAVES * 64, LDS_BYTES) != hipSuccess || per_cu < 1) { fprintf(stderr, "kernel_launch: occupancy query says %d\n", per_cu); per_cu = 1; }
        (void)hipGetLastError();
        grid = cus;
    }
    if (grid < 0) return;
    (void)hipMemsetAsync((char*)d_ws + WS_CTL, 0, CTL_ZERO_BYTES, stream);
    Args a{};
    for (int i = 0; i < 13; ++i) a.in[i] = (const float*)d_in[i];
    a.out = (float*)d_out; a.ws = (unsigned char*)d_ws;
#if MK_ONE_LAUNCH
    a.ph_lo = 0; a.ph_hi = NPHASE;
    hipLaunchKernelGGL(fwd_kernel, dim3(grid), dim3(NWAVES * 64), LDS_BYTES, stream, a);
#else
    for (int ph = 0; ph < NPHASE; ++ph) { a.ph_lo = ph; a.ph_hi = ph + 1;
        hipLaunchKernelGGL(fwd_kernel, dim3(grid), dim3(NWAVES * 64), LDS_BYTES, stream, a); }
#endif
}
```

```cpp
#include <hip/hip_runtime.h>
#include <cstdio>
#include <cstdint>
namespace pg8 {
#define PG8_LAS __attribute__((address_space(3)))
typedef unsigned short bf16_t;
typedef short bf16x8 __attribute__((ext_vector_type(8)));
typedef float f32x4 __attribute__((ext_vector_type(4)));
typedef unsigned u32x4 __attribute__((ext_vector_type(4)));
constexpr int BM = 256, BK = 64, HALF = 128, HTB = HALF * BK * 2  , STAGE_BYTES = 8 * HTB, NXCD = 8, WGM = 8;

__host__ __device__ __forceinline__ int lds_byte(int r, int c) { const int st = (r >> 4) * 2 + (c >> 5), rr = r & 15, cc = c & 31, ob = rr * 64 + cc * 2; return st * 1024 + (ob ^ (((ob >> 9) & 1) << 5)); }
__host__ __device__ __forceinline__ void stage_rc(int b, int& R, int& C) { const int st = b / 1024, sb = b % 1024, swz = sb ^ (((sb >> 9) & 1) << 5); R = (st >> 1) * 16 + swz / 64; C = (st & 1) * 32 + (swz % 64) / 2; }
__host__ __device__ __forceinline__ int perm32(int rho) { const int n = rho >> 4, i = rho & 15; return 8 * (i >> 2) + 4 * n + (i & 3); }

struct Unit { int pm, pn; };
struct Gemm { const bf16_t* A; const bf16_t* Bt; int M, N, K; };

struct StaticOrder {
    int nM, nN, nwg, G, c;
    __host__ __device__ void init(int M, int N, int G_, int c_) { nM = M / BM; nN = N / BM; nwg = nM * nN; G = G_; c = c_; }
    __host__ __device__ bool next(int i, Unit& u) const {
        const long L = (long)i * G + c; if (L >= nwg) return false;
        int wgid = (int)L; { const int q = nwg / NXCD, r = nwg % NXCD, xcd = wgid % NXCD, off = wgid / NXCD; wgid = (xcd < r ? xcd * (q + 1) : r * (q + 1) + (xcd - r) * q) + off; }
        const int nig = WGM * nN, gid = wgid / nig, fm = gid * WGM, gsz = (nM - fm) < WGM ? (nM - fm) : WGM;
        u.pm = fm + ((wgid % nig) % gsz); u.pn = (wgid % nig) / gsz; return true;
    }
    __device__ __forceinline__ void a_ready(const Unit&) const {}
    __device__ __forceinline__ void done(const Unit&) const {}
};

__device__ __forceinline__ unsigned cvt_pk_bf16(float lo, float hi) { unsigned r; asm volatile("v_cvt_pk_bf16_f32 %0, %1, %2" : "=v"(r) : "v"(lo), "v"(hi)); return r; }
typedef float f32x2 __attribute__((ext_vector_type(2)));
__device__ __forceinline__ f32x2 gelu_pk(f32x2 v) {
    const f32x2 av = __builtin_elementwise_abs(v), d = av * 0.2316418882f + 1.0f;
    f32x2 t; t.x = __builtin_amdgcn_rcpf(d.x); t.y = __builtin_amdgcn_rcpf(d.y);
    f32x2 q = t * 0.5307027145f + (-0.7265760135f); q = q * t + 0.7107068705f; q = q * t + (-0.142248368f); q = q * t + 0.127414796f; q = q * t;
    const f32x2 s = (v * v) * (-0.72134752044f);
    f32x2 e; e.x = __builtin_amdgcn_exp2f(s.x); e.y = __builtin_amdgcn_exp2f(s.y);
    const f32x2 m = v * (q * e), r = v - m;
    f32x2 o; o.x = v.x < 0.f ? m.x : r.x; o.y = v.y < 0.f ? m.y : r.y; return o;
}

template <int ACT  > struct EpiBf16 {
    static constexpr bool PERM = true, AFTER_DRAIN = false; static_assert(ACT == 0 || ACT == 1, "EpiBf16: ACT is 0 (none) or 1 (gelu_pk)");
    bf16_t* O; int ldc; const float* bias; int split_cols; size_t split_stride; float scale0;
    __device__ __forceinline__ void operator()(const f32x4 (&acc)[2][2][4][2], const Unit& u, int wr, int wc, int fr, int fq) const {
        const int row0 = u.pm * BM + wr * 64 + fr; int colt = u.pn * BM; bf16_t* base = O;
        float sc = 1.f; if (split_cols) { const int t = colt / split_cols; base += (size_t)t * split_stride; colt -= t * split_cols; if (t == 0) sc = scale0; }
        const int col0 = colt + wc * 32 + 8 * fq, bcol0 = u.pn * BM + wc * 32 + 8 * fq;
        f32x4 bv[2][2];
#pragma unroll
        for (int bj = 0; bj < 2; ++bj)
#pragma unroll
            for (int n = 0; n < 2; ++n) bv[bj][n] = bias ? *(const f32x4*)(bias + bcol0 + bj * HALF + 4 * n) : (f32x4){0.f, 0.f, 0.f, 0.f};
#pragma unroll
        for (int ai = 0; ai < 2; ++ai)
#pragma unroll
            for (int m = 0; m < 4; ++m) { bf16_t* rowp = base + (size_t)(row0 + ai * HALF + m * 16) * ldc + col0;
#pragma unroll
                for (int bj = 0; bj < 2; ++bj) { f32x4 v0 = acc[ai][bj][m][0] + bv[bj][0], v1 = acc[ai][bj][m][1] + bv[bj][1];
                    if (ACT == 1) { f32x2 a = gelu_pk((f32x2){v0[0], v0[1]}), b = gelu_pk((f32x2){v0[2], v0[3]}), c = gelu_pk((f32x2){v1[0], v1[1]}), d = gelu_pk((f32x2){v1[2], v1[3]});
                        v0 = (f32x4){a.x, a.y, b.x, b.y}; v1 = (f32x4){c.x, c.y, d.x, d.y}; }
                    v0 = v0 * sc; v1 = v1 * sc; u32x4 w; w.x = cvt_pk_bf16(v0[0], v0[1]); w.y = cvt_pk_bf16(v0[2], v0[3]); w.z = cvt_pk_bf16(v1[0], v1[1]); w.w = cvt_pk_bf16(v1[2], v1[3]);
                    *(u32x4*)(rowp + bj * HALF) = w; } }
    }
};
struct EpiResF32 {
    static constexpr bool PERM = false, AFTER_DRAIN = false;
    const float* base; float* out; int ldc;
    __device__ __forceinline__ void operator()(const f32x4 (&acc)[2][2][4][2], const Unit& u, int wr, int wc, int fr, int fq) const {
        const int row0 = u.pm * BM + wr * 64 + fr, col0 = u.pn * BM + wc * 32 + 4 * fq;
#pragma unroll
        for (int ai = 0; ai < 2; ++ai)
#pragma unroll
            for (int m = 0; m < 4; ++m) { const size_t off = (size_t)(row0 + ai * HALF + m * 16) * ldc + col0;
#pragma unroll
                for (int bj = 0; bj < 2; ++bj)
#pragma unroll
                    for (int n = 0; n < 2; ++n) { const f32x4 bs = *(const f32x4*)(base + off + bj * HALF + n * 16); *(f32x4*)(out + off + bj * HALF + n * 16) = bs + acc[ai][bj][m][n]; }
                if (m & 1) asm volatile("" ::: "memory"); }
    }
};
__host__ __device__ __forceinline__ int origcol0(int np) {
    const int tile = np >> 8, c = np & 255;
    if (tile < 24) { const int bj = c >> 7, wc = (c >> 5) & 3, n = (c >> 4) & 1, q = 2 * bj + n; const int qoff = (q == 0) ? 0 : (q == 1) ? 1536 : (q == 2) ? 3072 : 5120; return qoff + 64 * tile + 16 * wc + (c & 15); }
    const int zc = 256 * (tile - 24) + (c & ~31) + perm32(c & 31);
    return zc < 512 ? 4608 + zc : 6656 + (zc - 512);
}
template <int CTRL> __device__ __forceinline__ float dpp_f(float v) { return __builtin_bit_cast(float, __builtin_amdgcn_update_dpp(0, __builtin_bit_cast(int, v), CTRL, 0xf, 0xf, false)); }
__device__ __forceinline__ f32x4 ror1(f32x4 v) { return (f32x4){dpp_f<0x121>(v[0]), dpp_f<0x121>(v[1]), dpp_f<0x121>(v[2]), dpp_f<0x121>(v[3])}; }
__device__ __forceinline__ f32x4 ror15(f32x4 v) { return (f32x4){dpp_f<0x12f>(v[0]), dpp_f<0x12f>(v[1]), dpp_f<0x12f>(v[2]), dpp_f<0x12f>(v[3])}; }
__device__ __forceinline__ float silu_f(float g) { return g * __builtin_amdgcn_rcpf(1.0f + __builtin_amdgcn_exp2f(-1.4426950408889634f * g)); }
constexpr int EDGE_TILE_FLOATS = 2 * 3 * 1536;
struct EpiConv {
    static constexpr bool PERM = false, AFTER_DRAIN = false;
    bf16_t* Y; bf16_t* ZX; float* EDGE; const float* cw; const float* cb; PG8_LAS unsigned char* xl;
    __device__ __forceinline__ void operator()(const f32x4 (&acc)[2][2][4][2], const Unit& u, int wr, int wc, int fr, int fq) const {
        if (u.pn >= 24) {
            const int row0 = u.pm * BM + wr * 64 + fr, col0 = (u.pn - 24) * BM + wc * 32 + 8 * fq;
#pragma unroll
            for (int ai = 0; ai < 2; ++ai)
#pragma unroll
                for (int m = 0; m < 4; ++m) { bf16_t* rowp = ZX + (size_t)(row0 + ai * HALF + m * 16) * 1024 + col0;
#pragma unroll
                    for (int bj = 0; bj < 2; ++bj) { const f32x4 v0 = acc[ai][bj][m][0], v1 = acc[ai][bj][m][1];
                        u32x4 w; w.x = cvt_pk_bf16(v0[0], v0[1]); w.y = cvt_pk_bf16(v0[2], v0[3]); w.z = cvt_pk_bf16(v1[0], v1[1]); w.w = cvt_pk_bf16(v1[2], v1[3]);
                        *(u32x4*)(rowp + bj * HALF) = w; } }
            return;
        }
        const int lane = fq * 16 + fr, wid = wr * 4 + wc, chl = 16 * wc + 4 * fq, ch0 = 64 * u.pn + chl;
        const f32x4 w0 = *(const f32x4*)(cw + ch0), w1 = *(const f32x4*)(cw + 1536 + ch0), w2 = *(const f32x4*)(cw + 3072 + ch0), bb = *(const f32x4*)(cb + ch0);
        PG8_LAS float* xb = (PG8_LAS float*)(xl + 16384);
        f32x4 v[2][4];
#pragma unroll
        for (int ai = 0; ai < 2; ++ai) {
#pragma unroll
            for (int m = 0; m < 4; ++m) v[ai][m] = acc[ai][0][m][1] * acc[ai][1][m][0];
            const int blk = 2 * ai + wr;
            if (fr == 0) *(PG8_LAS f32x4*)(xb + (blk * 2 + 0) * 64 + chl) = v[ai][0];
            if (fr == 15) *(PG8_LAS f32x4*)(xb + (blk * 2 + 1) * 64 + chl) = v[ai][3];
        }
        asm volatile("s_waitcnt lgkmcnt(0)" ::: "memory"); __builtin_amdgcn_s_barrier(); asm volatile("" ::: "memory");
        const f32x4 zero4 = (f32x4){0.f, 0.f, 0.f, 0.f};
#pragma unroll
        for (int ai = 0; ai < 2; ++ai) {
            const int blk = 2 * ai + wr;
            f32x4 vprev = zero4, vnext = zero4;
            if (blk > 0) vprev = *(const PG8_LAS f32x4*)(xb + ((blk - 1) * 2 + 1) * 64 + chl);
            if (blk < 3) vnext = *(const PG8_LAS f32x4*)(xb + ((blk + 1) * 2 + 0) * 64 + chl);
#pragma unroll
            for (int m = 0; m < 4; ++m) {
                const f32x4 vc = v[ai][m];
                const f32x4 upa = ror1(vc), upb = (m > 0) ? ror1(v[ai][m > 0 ? m - 1 : 0]) : vprev;
                const f32x4 dna = ror15(vc), dnb = (m < 3) ? ror15(v[ai][m < 3 ? m + 1 : 3]) : vnext;
                const f32x4 up = (fr > 0) ? upa : upb, dn = (fr < 15) ? dna : dnb;
                const f32x4 conv = w0 * up + w1 * vc + w2 * dn + bb;
                const f32x4 p0 = acc[ai][0][m][0], gt = acc[ai][1][m][1];
                f32x4 pg, yv;
#pragma unroll
                for (int e = 0; e < 4; ++e) { pg[e] = p0[e] * silu_f(gt[e]); yv[e] = pg[e] * conv[e]; }
                if ((blk == 0 && m == 0 && fr == 0) || (blk == 3 && m == 3 && fr == 15)) {
                    float* eb = EDGE + (size_t)u.pm * EDGE_TILE_FLOATS + (blk == 0 ? 0 : 3 * 1536) + ch0;
                    *(f32x4*)(eb) = pg; *(f32x4*)(eb + 1536) = vc; *(f32x4*)(eb + 3072) = yv;
                }
                const int row = wr * 64 + m * 16 + fr;
                typedef unsigned u32x2 __attribute__((ext_vector_type(2)));
                u32x2 pk; pk.x = cvt_pk_bf16(yv[0], yv[1]); pk.y = cvt_pk_bf16(yv[2], yv[3]);
                *(PG8_LAS u32x2*)(xl + row * 128 + (((chl >> 2) ^ (row & 15)) << 3)) = pk;
            }
            asm volatile("s_waitcnt lgkmcnt(0)" ::: "memory"); __builtin_amdgcn_s_barrier(); asm volatile("" ::: "memory");
#pragma unroll
            for (int i = 0; i < 2; ++i) {
                const int idx = i * 512 + wid * 64 + lane, row = idx >> 3, c8 = idx & 7;
                u32x4 ov = *(const PG8_LAS u32x4*)(xl + row * 128 + (((2 * c8) ^ (row & 14)) << 3));
                if (row & 1) ov = (u32x4){ov.z, ov.w, ov.x, ov.y};
                *(u32x4*)(Y + (size_t)(u.pm * BM + ai * HALF + row) * 2048 + 64 * u.pn + c8 * 8) = ov;
            }
            if (ai == 0) { asm volatile("s_waitcnt lgkmcnt(0)" ::: "memory"); __builtin_amdgcn_s_barrier(); asm volatile("" ::: "memory"); }
        }
    }
};
struct EpiRes2 {
    static constexpr bool PERM = false, AFTER_DRAIN = false;
    const float* b0; const float* b1; float* out; int split_pm;
    __device__ __forceinline__ void operator()(const f32x4 (&acc)[2][2][4][2], const Unit& u, int wr, int wc, int fr, int fq) const {
        const int row0 = u.pm * BM + wr * 64 + fr, col0 = u.pn * BM + wc * 32 + 4 * fq;
        const float* bsel = (u.pm < split_pm) ? b0 + (size_t)row0 * 1024 : b1 + (size_t)(row0 - split_pm * BM) * 1024;
        float* osel = out + (size_t)row0 * 1024;
#pragma unroll
        for (int ai = 0; ai < 2; ++ai)
#pragma unroll
            for (int m = 0; m < 4; ++m) { const size_t off = (size_t)(ai * HALF + m * 16) * 1024 + col0;
#pragma unroll
                for (int bj = 0; bj < 2; ++bj)
#pragma unroll
                    for (int n = 0; n < 2; ++n) { const f32x4 bs = *(const f32x4*)(bsel + off + bj * HALF + n * 16); *(f32x4*)(osel + off + bj * HALF + n * 16) = bs + acc[ai][bj][m][n]; }
                if (m & 1) asm volatile("" ::: "memory"); }
    }
};
template <class Epi, class Sched, bool ALIGN_EPI = false, bool SP2 = false>
__device__ __forceinline__ void gemm_phase(PG8_LAS unsigned char* lds, const Gemm g, const Sched& S, const Epi& E, const int tid) {
    const int wid = __builtin_amdgcn_readfirstlane(tid >> 6), lane = tid & 63, wr = wid >> 2, wc = wid & 3, fr = lane & 15, fq = lane >> 4;
    const int K = g.K, nt = K / BK;
    unsigned voffA[2], voffB[2];
#pragma unroll
    for (int i = 0; i < 2; ++i) { int R, C; stage_rc(tid * 16 + i * 8192, R, C); const int Rb = Epi::PERM ? ((R & ~31) + perm32(R & 31)) : R;
        voffA[i] = (unsigned)(R * K + C) * 2u; voffB[i] = (unsigned)(Rb * K + C) * 2u; }
    const size_t kstep = (size_t)(BK * 2);
    const size_t hstep = (size_t)HALF * K * 2;
    const size_t tstep = 2 * hstep;
    const unsigned ldsw = (unsigned)wid * 1024u;
    const int aoff = lds_byte(wr * 64 + fr, fq * 8), boff = lds_byte(wc * 32 + fr, fq * 8);
#define PG8_SA(b, h) (((b) * 2 + (h)) * HTB)
#define PG8_SB(b, h) ((4 + (b) * 2 + (h)) * HTB)
#define PG8_STAGE(bufoff, gbase, voff) do { _Pragma("unroll") for (int _i = 0; _i < 2; ++_i) \
        __builtin_amdgcn_global_load_lds((const unsigned*)((const char*)(gbase) + (voff)[_i]), (PG8_LAS unsigned*)(lds + (bufoff) + ldsw + _i * 8192), 16, 0, 0); } while (0)
#define PG8_LDA(dst, b, h) do { _Pragma("unroll") for (int m = 0; m < 4; ++m) _Pragma("unroll") for (int k = 0; k < 2; ++k) dst[m][k] = *(const PG8_LAS bf16x8*)(lds + PG8_SA(b, h) + aoff + m * 2048 + k * 1024); } while (0)
#define PG8_LDB(dst, b, h) do { _Pragma("unroll") for (int n = 0; n < 2; ++n) _Pragma("unroll") for (int k = 0; k < 2; ++k) dst[n][k] = *(const PG8_LAS bf16x8*)(lds + PG8_SB(b, h) + boff + n * 2048 + k * 1024); } while (0)
#define PG8_MMA(ai, bj, At, Bt) do { __builtin_amdgcn_s_setprio(1); _Pragma("unroll") for (int m = 0; m < 4; ++m) _Pragma("unroll") for (int n = 0; n < 2; ++n) _Pragma("unroll") for (int k = 0; k < 2; ++k) \
        acc[ai][bj][m][n] = __builtin_amdgcn_mfma_f32_16x16x32_bf16(Bt[n][k], At[m][k], acc[ai][bj][m][n], 0, 0, 0); __builtin_amdgcn_s_setprio(0); } while (0)
#define PG8_WAIT_V(n) asm volatile("s_waitcnt vmcnt(" #n ")" ::: "memory")
#define PG8_WAIT_L(n) asm volatile("s_waitcnt lgkmcnt(" #n ")" ::: "memory")
#define PG8_BAR __builtin_amdgcn_s_barrier()
#define PG8_SCHED __builtin_amdgcn_sched_barrier(0)
    Unit cur, nxt; int ui = 0;
    if (!S.next(0, cur)) return;
    f32x4 acc[2][2][4][2];
#pragma unroll
    for (int a = 0; a < 2; ++a)
#pragma unroll
        for (int b = 0; b < 2; ++b)
#pragma unroll
            for (int m = 0; m < 4; ++m)
#pragma unroll
                for (int n = 0; n < 2; ++n) acc[a][b][m][n] = (f32x4){0.f, 0.f, 0.f, 0.f};
    bf16x8 At[4][2], B0[2][2], B1[2][2];
    const char* cA = (const char*)g.A + (size_t)cur.pm * tstep; const char* cB = (const char*)g.Bt + (size_t)cur.pn * tstep;
    S.a_ready(cur);
    if constexpr (SP2) {
        PG8_STAGE(PG8_SB(0, 0), cB, voffB); PG8_STAGE(PG8_SB(0, 1), cB + hstep, voffB); PG8_STAGE(PG8_SA(0, 0), cA, voffA); PG8_STAGE(PG8_SA(0, 1), cA + hstep, voffA);
        if (wr == 1) PG8_BAR;
        PG8_WAIT_V(2); PG8_BAR;
        PG8_STAGE(PG8_SB(1, 0), cB + kstep, voffB); PG8_STAGE(PG8_SA(1, 0), cA + kstep, voffA); PG8_STAGE(PG8_SB(1, 1), cB + hstep + kstep, voffB);
        PG8_WAIT_V(6); PG8_BAR;
    } else {
        PG8_STAGE(PG8_SB(0, 0), cB, voffB); PG8_STAGE(PG8_SA(0, 0), cA, voffA); PG8_STAGE(PG8_SB(0, 1), cB + hstep, voffB); PG8_STAGE(PG8_SA(0, 1), cA + hstep, voffA);
        if (wr == 1) PG8_BAR;
        PG8_WAIT_V(4); PG8_BAR;
        PG8_STAGE(PG8_SB(1, 0), cB + kstep, voffB); PG8_STAGE(PG8_SA(1, 0), cA + kstep, voffA); PG8_STAGE(PG8_SB(1, 1), cB + hstep + kstep, voffB);
        PG8_WAIT_V(6); PG8_BAR;
    }
    for (;;) {
        const bool has_next = S.next(ui + 1, nxt);
        const char* nA = has_next ? (const char*)g.A + (size_t)nxt.pm * tstep : cA; const char* nB = has_next ? (const char*)g.Bt + (size_t)nxt.pn * tstep : cB;
        for (int t = 0; t < nt; t += 2) {
            const bool last = (t == nt - 2);
            const char* a1 = cA + (size_t)(t + 1) * kstep;
            const char* a2 = last ? nA : cA + (size_t)(t + 2) * kstep; const char* b2 = last ? nB : cB + (size_t)(t + 2) * kstep;
            const char* a3 = a2 + kstep; const char* b3 = b2 + kstep;
            if (last && has_next) S.a_ready(nxt);
            if constexpr (SP2) {
            PG8_LDB(B0, 0, 0); PG8_LDB(B1, 0, 1); PG8_SCHED; PG8_LDA(At, 0, 0); PG8_STAGE(PG8_SA(1, 1), a1 + hstep, voffA);
            PG8_WAIT_V(8); PG8_WAIT_L(0); PG8_BAR; PG8_MMA(0, 0, At, B0); PG8_MMA(0, 1, At, B1); PG8_BAR; PG8_SCHED;
            PG8_LDA(At, 0, 1); PG8_STAGE(PG8_SB(0, 0), b2, voffB); PG8_STAGE(PG8_SB(0, 1), b2 + hstep, voffB); PG8_STAGE(PG8_SA(0, 0), a2, voffA);
            PG8_WAIT_V(8); PG8_WAIT_L(0); PG8_BAR; PG8_MMA(1, 0, At, B0); PG8_MMA(1, 1, At, B1); PG8_BAR; PG8_SCHED;
            PG8_LDB(B0, 1, 0); PG8_LDB(B1, 1, 1); PG8_SCHED; PG8_LDA(At, 1, 0); PG8_STAGE(PG8_SA(0, 1), a2 + hstep, voffA);
            PG8_WAIT_V(8); PG8_WAIT_L(0); PG8_BAR; PG8_MMA(0, 0, At, B0); PG8_MMA(0, 1, At, B1); PG8_BAR; PG8_SCHED;
            PG8_LDA(At, 1, 1); PG8_STAGE(PG8_SB(1, 0), b3, voffB); PG8_STAGE(PG8_SB(1, 1), b3 + hstep, voffB); PG8_STAGE(PG8_SA(1, 0), a3, voffA);
            PG8_WAIT_V(8); PG8_WAIT_L(0); PG8_BAR; PG8_MMA(1, 0, At, B0); PG8_MMA(1, 1, At, B1); PG8_BAR; PG8_SCHED;
            } else {
            PG8_LDB(B0, 0, 0); PG8_SCHED; PG8_LDA(At, 0, 0); PG8_STAGE(PG8_SA(1, 1), a1 + hstep, voffA);
            PG8_WAIT_L(8); PG8_BAR; PG8_WAIT_L(0); PG8_MMA(0, 0, At, B0); PG8_BAR; PG8_SCHED;
            PG8_LDB(B1, 0, 1); PG8_STAGE(PG8_SB(0, 0), b2, voffB);
            PG8_BAR; PG8_WAIT_L(0); PG8_MMA(0, 1, At, B1); PG8_BAR;
            PG8_LDA(At, 0, 1); PG8_STAGE(PG8_SA(0, 0), a2, voffA);
            PG8_BAR; PG8_WAIT_L(0); PG8_MMA(1, 0, At, B0); PG8_BAR; PG8_SCHED;
            PG8_STAGE(PG8_SB(0, 1), b2 + hstep, voffB);
            PG8_WAIT_V(6); PG8_BAR; PG8_MMA(1, 1, At, B1); PG8_BAR;
            PG8_LDB(B0, 1, 0); PG8_SCHED; PG8_LDA(At, 1, 0); PG8_STAGE(PG8_SA(0, 1), a2 + hstep, voffA);
            PG8_WAIT_L(8); PG8_BAR; PG8_WAIT_L(0); PG8_MMA(0, 0, At, B0); PG8_BAR; PG8_SCHED;
            PG8_LDB(B1, 1, 1); PG8_STAGE(PG8_SB(1, 0), b3, voffB);
            PG8_BAR; PG8_WAIT_L(0); PG8_MMA(0, 1, At, B1); PG8_BAR;
            PG8_LDA(At, 1, 1); PG8_STAGE(PG8_SA(1, 0), a3, voffA);
            PG8_BAR; PG8_WAIT_L(0); PG8_MMA(1, 0, At, B0); PG8_BAR; PG8_SCHED;
            PG8_STAGE(PG8_SB(1, 1), b3 + hstep, voffB);
            PG8_WAIT_V(6); PG8_BAR; PG8_MMA(1, 1, At, B1); PG8_BAR;
            }
        }
        if constexpr (ALIGN_EPI) { if (wr == 0) PG8_BAR; }
        if constexpr (!Epi::AFTER_DRAIN) { E(acc, cur, wr, wc, fr, fq); S.done(cur); }
        if (!has_next) break;
#pragma unroll
        for (int a = 0; a < 2; ++a)
#pragma unroll
            for (int b = 0; b < 2; ++b)
#pragma unroll
                for (int m = 0; m < 4; ++m)
#pragma unroll
                    for (int n = 0; n < 2; ++n) acc[a][b][m][n] = (f32x4){0.f, 0.f, 0.f, 0.f};
        cur = nxt; cA = nA; cB = nB; ++ui;
        if constexpr (ALIGN_EPI) { if (wr == 1) PG8_BAR; }
    }
    PG8_WAIT_V(0);
    if constexpr (!ALIGN_EPI) { if (wr == 0) PG8_BAR; }
    PG8_BAR;
    if constexpr (Epi::AFTER_DRAIN) { E.fused(acc, cur, wr, wc, fr, fq, lds, wid, lane); S.done(cur); }
#undef PG8_SA
#undef PG8_SB
#undef PG8_STAGE
#undef PG8_LDA
#undef PG8_LDB
#undef PG8_MMA
#undef PG8_WAIT_V
#undef PG8_WAIT_L
#undef PG8_BAR
#undef PG8_SCHED
}
}
#ifndef MK_ONE_LAUNCH
#define MK_ONE_LAUNCH 1
#endif
constexpr int NWAVES = 8;
constexpr int DM = 1024, INW = 7168, BRW = 2048, MIXW = 1536, XW = 512;
constexpr int TOK = 49152, CH = 16384, NCH = 3;
constexpr int MEMROWS = 1280;
constexpr int NAH = 24, XH = 4;
constexpr int ZQ = 0, ZK = 1536, ZV = 3072, ZQM = 4608, ZG = 5120;
constexpr float RMS_EPS = 1e-6f;
constexpr size_t MiB = 1u << 20;
constexpr size_t WS_CTL = 0, CTL_ZERO_BYTES = 1 * MiB;
constexpr size_t WS_W1T = 2 * MiB;
constexpr size_t WS_W2T = 30 * MiB;
constexpr size_t WS_WKVT = 38 * MiB;
constexpr size_t WS_MEMN = 42 * MiB;
constexpr size_t WS_MKV = 47 * MiB;
constexpr size_t WS_KIMG = 52 * MiB;
constexpr size_t WS_VTIMG = 55 * MiB;
constexpr size_t WS_EDGE = 58 * MiB;
constexpr size_t WS_HB = 66 * MiB;
constexpr size_t WS_A = 162 * MiB;
constexpr size_t WS_YF = WS_A, WS_ZX = WS_A + 192 * MiB, WS_Z = WS_A, WS_Y = WS_A + 224 * MiB;
constexpr size_t WS_END = 450 * MiB;
constexpr int CW_BAR = 4096;
constexpr int RING_OFF = 0, RING_BYTES = 131072;
constexpr int LDSCTL_OFF = RING_BYTES, MISC_OFF = LDSCTL_OFF + 320;
constexpr int LDS_BYTES = 163840;
constexpr int PH_PREP = 0, PH_MKV = 1, PH_IMG = 2, PH_G1_0 = 3, PH_MIX_0 = 4, PH_G2_0 = 5, PH_NORM_0 = 6, PH_L1 = 7, PH_NORM_1 = 16, NPHASE = 17;
constexpr int XL_OFF = RING_BYTES + 1024;

#define GAS __attribute__((address_space(1)))
#define LAS __attribute__((address_space(3)))
typedef unsigned short bf16;
typedef unsigned v4u __attribute__((ext_vector_type(4)));
typedef float f32x4 __attribute__((ext_vector_type(4)));
typedef GAS unsigned gu32;
#define RLX_AGENT __ATOMIC_RELAXED, __HIP_MEMORY_SCOPE_AGENT
#define LDS_WAIT() asm volatile("s_waitcnt lgkmcnt(0)" ::: "memory")
__device__ __forceinline__ unsigned f2bf(float f) { unsigned u = __builtin_bit_cast(unsigned, f); return (u + 0x7fffu + ((u >> 16) & 1u)) >> 16; }
__device__ __forceinline__ unsigned pk2(float lo, float hi) { return f2bf(lo) | (f2bf(hi) << 16); }
__device__ __forceinline__ float bf2f(unsigned short b) { return __uint_as_float((unsigned)b << 16); }
__device__ __forceinline__ float bflo(unsigned w) { return __uint_as_float(w << 16); }
__device__ __forceinline__ float bfhi(unsigned w) { return __uint_as_float(w & 0xffff0000u); }
__device__ __forceinline__ float silu(float g) { return g / (1.0f + __expf(-g)); }
__device__ __forceinline__ float wave_sum(float v) {
#pragma unroll
    for (int o = 1; o < 64; o <<= 1) v += __shfl_xor(v, o);
    return v;
}
__device__ __forceinline__ float wave_max(float v) {
#pragma unroll
    for (int o = 1; o < 64; o <<= 1) v = fmaxf(v, __shfl_xor(v, o));
    return v;
}
template <int OFF> __device__ __forceinline__ unsigned long long karg64() {
    unsigned long long v; auto ka = __builtin_amdgcn_kernarg_segment_ptr();
    asm volatile("s_load_dwordx2 %0, %1, %2\n\ts_waitcnt lgkmcnt(0)" : "=s"(v) : "s"(ka), "i"(OFF) : "memory");
    return v;
}
#define XB_TMO      128
#define XB_XCNT(j)  (256  + 64 * (j))
#define XB_XSUB(j)  (1280 + 64 * (j))
#define XB_XGEN(j)  (2304 + 64 * (j))
#define XB_TOP      3328
#define XB_TOPGEN   3392
#define XCD_BAR_WORDS 3456
#define XB_SPIN_CAP (1u << 18)

__device__ __forceinline__ unsigned xb_ld(unsigned* p)              { return __hip_atomic_load(p, __ATOMIC_RELAXED, __HIP_MEMORY_SCOPE_AGENT); }
__device__ __forceinline__ unsigned xb_add(unsigned* p, unsigned v) { return __hip_atomic_fetch_add(p, v, __ATOMIC_RELAXED, __HIP_MEMORY_SCOPE_AGENT); }
__device__ __forceinline__ unsigned xb_xcc_id() { return (unsigned)__builtin_amdgcn_s_getreg((3 << 11) | 20) & 0xFu; }
#define XB_SPIN(cond, bar) do { unsigned _sp = 0; while (cond) { __builtin_amdgcn_s_sleep(1); \
    if ((++_sp & 255u) == 0u) { if (xb_ld(&(bar)[XB_TMO])) break; if (_sp > XB_SPIN_CAP) { atomicAdd(&(bar)[XB_TMO], 1u); break; } } } } while (0)

struct XcdBarrier {
    unsigned* bar; unsigned x;
    volatile LAS unsigned* st;
};

__device__ __forceinline__ XcdBarrier xcd_barrier_post(unsigned* bar, volatile LAS unsigned* st) {
    XcdBarrier b; b.bar = bar; b.x = xb_xcc_id(); b.st = st;
    if (threadIdx.x == 0) (void)xb_add(&bar[XB_XCNT(b.x)], 1u);
    return b;
}
__device__ __forceinline__ void xcd_barrier_complete(unsigned* bar, unsigned x, unsigned& nloc, unsigned& nx) {
    const unsigned G = gridDim.x * gridDim.y * gridDim.z;
    unsigned sum, cnt, mine, sp = 0u;
    for (;;) {
        sum = 0u; cnt = 0u; mine = 0u;
#pragma unroll
        for (unsigned j = 0; j < 16; ++j) { const unsigned c = xb_ld(&bar[XB_XCNT(j)]); sum += c; cnt += (c > 0u) ? 1u : 0u; mine = (j == x) ? c : mine; }
        if (sum == G) break;
        __builtin_amdgcn_s_sleep(1);
        if ((++sp & 255u) == 0u) { if (xb_ld(&bar[XB_TMO])) break; if (sp > XB_SPIN_CAP) { atomicAdd(&bar[XB_TMO], 1u); break; } }
    }
    nloc = mine > 0u ? mine : 1u; nx = cnt > 0u ? cnt : 1u;
}

__device__ __forceinline__ void xcd_barrier(const XcdBarrier& b) {
    asm volatile("s_waitcnt vmcnt(0)" ::: "memory");
    __syncthreads();
    if (threadIdx.x == 0) {
        unsigned* bar = b.bar;
        __builtin_amdgcn_s_waitcnt(0);
        unsigned nloc = b.st[0], nx = b.st[1];
        if (nloc == 0u) { xcd_barrier_complete(bar, b.x, nloc, nx); b.st[0] = nloc; b.st[1] = nx; }
        const unsigned old = xb_add(&bar[XB_XSUB(b.x)], 1u);
        const unsigned gen = old / nloc;
        if (old + 1u == (gen + 1u) * nloc) {
            __builtin_amdgcn_fence(__ATOMIC_RELEASE, "agent");
            asm volatile("s_waitcnt vmcnt(0)" ::: "memory");
            const unsigned og = xb_add(&bar[XB_TOP], 1u);
            const unsigned tg = og / nx;
            if (og + 1u == (tg + 1u) * nx) xb_add(&bar[XB_TOPGEN], 1u);
            else XB_SPIN(xb_ld(&bar[XB_TOPGEN]) == tg, bar);
            __builtin_amdgcn_fence(__ATOMIC_ACQUIRE, "agent");
            xb_add(&bar[XB_XGEN(b.x)], 1u);
            asm volatile("s_waitcnt vmcnt(0)" ::: "memory");
        } else {
            XB_SPIN(xb_ld(&bar[XB_XGEN(b.x)]) == gen, bar);
            __builtin_amdgcn_fence(__ATOMIC_ACQUIRE, "agent");
            asm volatile("s_waitcnt vmcnt(0)" ::: "memory");
        }
    }
    __syncthreads();
}
template <bool MAP0> __device__ __forceinline__ void transpose_item(const float* W, int K, int N, bf16* WT, LAS float* scr, int item, int lane) {
    const int nblk = N / 32, kb = item / nblk, nb = item % nblk, k0 = 64 * kb, n0 = 32 * nb;
    const int csrc = MAP0 ? pg8::origcol0(n0 + (lane & 31)) : n0 + (lane & 31);
#pragma unroll 8
    for (int i = 0; i < 32; ++i) { const int kk = 2 * i + (lane >> 5); scr[kk * 33 + (lane & 31)] = W[(size_t)(k0 + kk) * N + csrc]; }
    LDS_WAIT(); asm volatile("" ::: "memory");
    const int c = lane & 7;
#pragma unroll
    for (int j = 0; j < 4; ++j) { const int n = (lane >> 3) + 8 * j; const LAS float* s = scr + (8 * c) * 33 + n;
        v4u o; o.x = pk2(s[0 * 33], s[1 * 33]); o.y = pk2(s[2 * 33], s[3 * 33]); o.z = pk2(s[4 * 33], s[5 * 33]); o.w = pk2(s[6 * 33], s[7 * 33]);
        *(GAS v4u*)(WT + (size_t)(n0 + n) * K + k0 + 8 * c) = o; }
    LDS_WAIT(); asm volatile("" ::: "memory");
}
__device__ __forceinline__ void rms_row_to_bf16(const float* xrow, const float* w, bf16* orow, int lane) {
    const GAS f32x4* xr = (const GAS f32x4*)xrow + lane; const GAS f32x4* wr = (const GAS f32x4*)w + lane;
    f32x4 v[4]; float s = 0.f;
#pragma unroll
    for (int j = 0; j < 4; ++j) { v[j] = xr[64 * j]; s += (v[j].x * v[j].x + v[j].y * v[j].y) + (v[j].z * v[j].z + v[j].w * v[j].w); }
    const float rstd = 1.f / sqrtf(wave_sum(s) * (1.f / DM) + RMS_EPS);
    GAS unsigned long long* o8 = (GAS unsigned long long*)orow + lane;
#pragma unroll
    for (int j = 0; j < 4; ++j) { const f32x4 ww = wr[64 * j];
        o8[64 * j] = (unsigned long long)pk2(v[j].x * rstd * ww.x, v[j].y * rstd * ww.y) | ((unsigned long long)pk2(v[j].z * rstd * ww.z, v[j].w * rstd * ww.w) << 32); }
}
__device__ __forceinline__ void rms_row_to_f32(const float* xrow, const float* w, float* orow, int lane) {
    const GAS f32x4* xr = (const GAS f32x4*)xrow + lane; const GAS f32x4* wr = (const GAS f32x4*)w + lane;
    f32x4 v[4]; float s = 0.f;
#pragma unroll
    for (int j = 0; j < 4; ++j) { v[j] = xr[64 * j]; s += (v[j].x * v[j].x + v[j].y * v[j].y) + (v[j].z * v[j].z + v[j].w * v[j].w); }
    const float rstd = 1.f / sqrtf(wave_sum(s) * (1.f / DM) + RMS_EPS);
    GAS f32x4* o = (GAS f32x4*)orow + lane;
#pragma unroll
    for (int j = 0; j < 4; ++j) { const f32x4 ww = wr[64 * j]; o[64 * j] = (v[j] * rstd) * ww; }
}

struct Ptrs {
    const float *xp, *xs, *memp, *mems, *norm_w, *w_in, *w_out, *mem_norm_w, *w_mem_kv, *conv_w, *conv_b, *na_rpb, *final_norm_w;
    float* out;
    bf16 *W1T, *W2T, *WKVT, *MEMN, *MKV, *HB, *Y, *Z;
    unsigned char *KIMG, *VTIMG;
    bf16 *YF, *ZX; float* EDGE;
};

__device__ __forceinline__ void phase_prep(const Ptrs& P, LAS unsigned char* lds, int gw, int NGW, int wave, int lane) {
    LAS float* scr = (LAS float*)(lds + RING_OFF + wave * 16384);
    constexpr int I_W1 = (DM / 64) * (INW / 32), I_W2 = (BRW / 64) * (DM / 32), I_KV = (DM / 64) * (DM / 32);
    constexpr int NITEMS = 2 * (I_W1 + I_W2 + I_KV);
    for (int it = gw; it < NITEMS; it += NGW) {
        int r = it;
        if (r < I_W1) { transpose_item<true>(P.w_in, DM, INW, P.W1T, scr, r, lane); continue; } r -= I_W1;
        if (r < I_W1) { transpose_item<false>(P.w_in + (size_t)DM * INW, DM, INW, P.W1T + (size_t)INW * DM, scr, r, lane); continue; } r -= I_W1;
        if (r < 2 * I_W2) { const int l = r / I_W2; transpose_item<false>(P.w_out + (size_t)l * BRW * DM, BRW, DM, P.W2T + (size_t)l * DM * BRW, scr, r % I_W2, lane); continue; } r -= 2 * I_W2;
        { const int l = r / I_KV; transpose_item<false>(P.w_mem_kv + (size_t)l * DM * DM, DM, DM, P.WKVT + (size_t)l * DM * DM, scr, r % I_KV, lane); }
    }
    for (int m = gw; m < 2 * MEMROWS; m += NGW) { const int l = m / MEMROWS, r = m % MEMROWS;
        const float* src = (r < 1024) ? P.memp + (size_t)r * DM : P.mems + (size_t)(r - 1024) * DM;
        rms_row_to_bf16(src, P.mem_norm_w + l * DM, P.MEMN + (size_t)m * DM, lane); }
    for (int m = gw; m < TOK; m += NGW) { const float* src = (m < 32768) ? P.xp + (size_t)m * DM : P.xs + (size_t)(m - 32768) * DM;
        rms_row_to_bf16(src, P.norm_w, P.HB + (size_t)m * DM, lane); }
}

__device__ __forceinline__ void phase_conv(const Ptrs& P, int chunk, int gt, int NGT) {
    const int seqlen = (chunk == 2) ? 16384 : 8192;
    const bf16* z = P.Z; bf16* y = P.Y;
    for (int it = gt; it < CH * (MIXW / 8); it += NGT) {
        const int tl = it / (MIXW / 8), cg = it % (MIXW / 8), ch = cg * 8;
        const int ts = tl % seqlen; const bool hp = ts > 0, hn = ts < seqlen - 1;
        const bf16* zr = z + (size_t)tl * INW + ch;
        const v4u p0 = *(const GAS v4u*)(zr + ZQ), p1 = *(const GAS v4u*)(zr + ZK), p2 = *(const GAS v4u*)(zr + ZV), gg = *(const GAS v4u*)(zr + ZG);
        v4u a1 = (v4u){0, 0, 0, 0}, a2 = a1, b1 = a1, b2 = a1;
        if (hp) { a1 = *(const GAS v4u*)(zr - INW + ZK); a2 = *(const GAS v4u*)(zr - INW + ZV); }
        if (hn) { b1 = *(const GAS v4u*)(zr + INW + ZK); b2 = *(const GAS v4u*)(zr + INW + ZV); }
        float cw0[8], cw1[8], cw2[8], cb[8];
#pragma unroll
        for (int j = 0; j < 8; ++j) { cw0[j] = P.conv_w[ch + j]; cw1[j] = P.conv_w[MIXW + ch + j]; cw2[j] = P.conv_w[2 * MIXW + ch + j]; cb[j] = P.conv_b[ch + j]; }
        v4u o;
#pragma unroll
        for (int w = 0; w < 4; ++w) {
            float r[2];
#pragma unroll
            for (int e = 0; e < 2; ++e) {
                const int j = 2 * w + e;
                const float vp = e ? bfhi(a1[w]) * bfhi(a2[w]) : bflo(a1[w]) * bflo(a2[w]);
                const float vc = e ? bfhi(p1[w]) * bfhi(p2[w]) : bflo(p1[w]) * bflo(p2[w]);
                const float vn = e ? bfhi(b1[w]) * bfhi(b2[w]) : bflo(b1[w]) * bflo(b2[w]);
                const float conv = vp * cw0[j] + vc * cw1[j] + vn * cw2[j] + cb[j];
                const float b = e ? bfhi(p0[w]) : bflo(p0[w]);
                const float g = e ? bfhi(gg[w]) : bflo(gg[w]);
                r[e] = b * conv * silu(g);
            }
            o[w] = pk2(r[0], r[1]);
        }
        *(GAS v4u*)(y + (size_t)tl * BRW + ch) = o;
    }
}

__device__ __forceinline__ void phase_na_naive(const Ptrs& P, int chunk, int gw, int NGW, int lane) {
    const int seqlen = (chunk == 2) ? 16384 : 8192; const int rows = seqlen / 64;
    const bf16* z = P.Z; bf16* y = P.Y; const float* rpb = P.na_rpb;
    for (int task = gw; task < CH * NAH; task += NGW) {
        const int tl = task / NAH, h = task % NAH;
        const int ss = (tl / seqlen) * seqlen, ts = tl - ss, r = ts >> 6, c = ts & 63;
        int r0 = r - 4; r0 = r0 < 0 ? 0 : (r0 > rows - 8 ? rows - 8 : r0);
        int c0 = c - 8; c0 = c0 < 0 ? 0 : (c0 > 48 ? 48 : c0);
        v4u qv[8];
        { const GAS v4u* qp = (const GAS v4u*)(z + (size_t)tl * INW + ZQ + h * 64);
#pragma unroll
          for (int i = 0; i < 8; ++i) qv[i] = qp[i]; }
        float lg[2];
#pragma unroll
        for (int u = 0; u < 2; ++u) {
            const int kk = lane + 64 * u, a = kk >> 4, j = kk & 15;
            const int kt = ss + (r0 + a) * 64 + c0 + j;
            const GAS v4u* kp = (const GAS v4u*)(z + (size_t)kt * INW + ZK + h * 64);
            float dot = 0.f;
#pragma unroll
            for (int i = 0; i < 8; ++i) { const v4u kv = kp[i];
#pragma unroll
                for (int w = 0; w < 4; ++w) dot += bflo(qv[i][w]) * bflo(kv[w]) + bfhi(qv[i][w]) * bfhi(kv[w]); }
            lg[u] = dot * 0.125f + rpb[(h * 15 + (r0 + a - r + 7)) * 31 + (c0 + j - c + 15)];
        }
        const float mx = wave_max(fmaxf(lg[0], lg[1]));
        float pe[2]; pe[0] = __expf(lg[0] - mx); pe[1] = __expf(lg[1] - mx);
        const float inv = 1.f / wave_sum(pe[0] + pe[1]);
        pe[0] *= inv; pe[1] *= inv;
        float o = 0.f;
#pragma unroll
        for (int u = 0; u < 2; ++u)
            for (int kl = 0; kl < 64; ++kl) {
                const float p = __shfl(pe[u], kl);
                const int kk = kl + 64 * u, a = kk >> 4, j = kk & 15;
                const int kt = ss + (r0 + a) * 64 + c0 + j;
                o += p * bf2f(z[(size_t)kt * INW + ZV + h * 64 + lane]);
            }
        const float g = bf2f(z[(size_t)tl * INW + ZG + h * 64 + lane]);
        y[(size_t)tl * BRW + h * 64 + lane] = (bf16)f2bf(o * silu(g));
    }
}

__device__ __forceinline__ void phase_xattn_naive(const Ptrs& P, int layer, int chunk, int gw, int NGW, int lane) {
    const bf16* z = P.Z; bf16* y = P.Y;
    for (int task = gw; task < CH * XH; task += NGW) {
        const int tl = task / XH, h = task % XH;
        const int g = chunk * CH + tl, s = (g < 32768) ? (g >> 13) : 4;
        const bf16* kb = P.MKV + ((size_t)layer * MEMROWS + s * 256) * DM + h * 128;
        const bf16* vb = kb + 512;
        v4u qv[16];
        { const GAS v4u* qp = (const GAS v4u*)(z + (size_t)tl * INW + ZQM + h * 128);
#pragma unroll
          for (int i = 0; i < 16; ++i) qv[i] = qp[i]; }
        float lg[4];
#pragma unroll
        for (int u = 0; u < 4; ++u) {
            const int key = lane + 64 * u;
            const GAS v4u* kp = (const GAS v4u*)(kb + (size_t)key * DM);
            float dot = 0.f;
#pragma unroll
            for (int i = 0; i < 16; ++i) { const v4u kv = kp[i];
#pragma unroll
                for (int w = 0; w < 4; ++w) dot += bflo(qv[i][w]) * bflo(kv[w]) + bfhi(qv[i][w]) * bfhi(kv[w]); }
            lg[u] = dot * 0.08838834764831845f;
        }
        const float mx = wave_max(fmaxf(fmaxf(lg[0], lg[1]), fmaxf(lg[2], lg[3])));
        float pe[4]; float sm = 0.f;
#pragma unroll
        for (int u = 0; u < 4; ++u) { pe[u] = __expf(lg[u] - mx); sm += pe[u]; }
        const float inv = 1.f / wave_sum(sm);
        float o0 = 0.f, o1 = 0.f;
#pragma unroll
        for (int u = 0; u < 4; ++u)
            for (int kl = 0; kl < 64; ++kl) {
                const float p = __shfl(pe[u], kl) * inv;
                const unsigned vv = *(const GAS unsigned*)(vb + (size_t)(kl + 64 * u) * DM + 2 * lane);
                o0 += p * bflo(vv); o1 += p * bfhi(vv);
            }
        const unsigned gg = *(const GAS unsigned*)(z + (size_t)tl * INW + ZG + MIXW + h * 128 + 2 * lane);
        *(GAS unsigned*)(y + (size_t)tl * BRW + MIXW + h * 128 + 2 * lane) = pk2(o0 * silu(bflo(gg)), o1 * silu(bfhi(gg)));
    }
}

__device__ __forceinline__ void phase_edgefix(const Ptrs& P, int gt, int NGT) {
    for (int it = gt; it < 192 * 2 * (MIXW / 4); it += NGT) {
        const int c4 = it % (MIXW / 4), tw = it / (MIXW / 4), which = tw & 1, pm = tw >> 1, ch = c4 * 4;
        const int t = pm * 256 + (which ? 255 : 0), tn = which ? t + 1 : t - 1;
        const bool has = which ? (tn < TOK && !((tn % 8192 == 0) && tn <= 32768)) : !((t % 8192 == 0) && t <= 32768);
        const float* eb = P.EDGE + (size_t)pm * pg8::EDGE_TILE_FLOATS + (which ? 3 * MIXW : 0) + ch;
        const f32x4 pg = *(const GAS f32x4*)(eb), yp = *(const GAS f32x4*)(eb + 2 * MIXW);
        f32x4 y = yp;
        if (has) { const int pn_ = which ? pm + 1 : pm - 1;
            const f32x4 vn = *(const GAS f32x4*)(P.EDGE + (size_t)pn_ * pg8::EDGE_TILE_FLOATS + (which ? 0 : 3 * MIXW) + MIXW + ch);
            const f32x4 w = *(const GAS f32x4*)(P.conv_w + (which ? 2 * MIXW : 0) + ch);
            y = yp + pg * w * vn; }
        typedef unsigned u32x2 __attribute__((ext_vector_type(2)));
        u32x2 o; o.x = pk2(y[0], y[1]); o.y = pk2(y[2], y[3]);
        *(GAS u32x2*)(P.YF + (size_t)t * BRW + ch) = o;
    }
}
namespace xa {
typedef short bf16x8 __attribute__((ext_vector_type(8)));
typedef float f32x16 __attribute__((ext_vector_type(16)));
typedef float f32x2_t __attribute__((ext_vector_type(2))); typedef __bf16 bf16x2_t __attribute__((ext_vector_type(2)));
typedef unsigned u32x4 __attribute__((ext_vector_type(4)));
__device__ __forceinline__ int crow(int r, int h) { return (r & 3) + 8 * (r >> 2) + 4 * h; }
__device__ __forceinline__ unsigned cvtpk(float lo, float hi) { f32x2_t v = {lo, hi}; bf16x2_t b = __builtin_convertvector(v, bf16x2_t); return __builtin_bit_cast(unsigned, b); }
__device__ __forceinline__ int pos2key16(int p) { return 8 * ((p & 7) >> 2) + 4 * (p >> 3) + (p & 3); }
constexpr int XSCR_OFF = RING_BYTES + 1024;
constexpr float C2 = 0.08838834764831845f * 1.4426950408889634f;

__device__ __forceinline__ void xattn_unit(LAS unsigned char* lds, const bf16* qsrc, int qld, const bf16* gsrc, int gld, bf16* yd, int yld, int row0, const unsigned char* kimg, const unsigned char* vtimg, int tid) {
    const int lane = tid & 63, wid = __builtin_amdgcn_readfirstlane(tid >> 6), r32 = lane & 31, hh = lane >> 5;
    { const unsigned char* src = (wid < 4 ? kimg : vtimg - 65536) + (size_t)wid * 16384 + lane * 16;
#pragma unroll
      for (int i = 0; i < 16; ++i) __builtin_amdgcn_global_load_lds((const GAS unsigned*)(src + i * 1024), (LAS unsigned*)(lds + wid * 16384 + i * 1024), 16, 0, 0); }
    bf16x8 qf[8];
    { const bf16* qp = qsrc + (size_t)(row0 + wid * 32 + r32) * qld + hh * 8;
#pragma unroll
      for (int ks = 0; ks < 8; ++ks) qf[ks] = *(const GAS bf16x8*)(qp + ks * 16); }
    asm volatile("s_waitcnt vmcnt(0)" ::: "memory");
    __syncthreads();
    f32x16 s[8];
#pragma unroll
    for (int kb = 0; kb < 8; ++kb) {
        const int key = kb * 32 + r32;
        f32x16 acc;
#pragma unroll
        for (int i = 0; i < 16; ++i) acc[i] = 0.f;
#pragma unroll
        for (int ks = 0; ks < 8; ++ks) {
            const bf16x8 a = *(const LAS bf16x8*)(lds + key * 256 + (((2 * ks + hh) ^ (key & 15)) << 4));
            acc = __builtin_amdgcn_mfma_f32_32x32x16_bf16(a, qf[ks], acc, 0, 0, 0);
        }
        s[kb] = acc;
    }
    float m = s[0][0];
#pragma unroll
    for (int kb = 0; kb < 8; ++kb)
#pragma unroll
        for (int r = 0; r < 16; ++r) m = fmaxf(m, s[kb][r]);
    m = fmaxf(m, __shfl_xor(m, 32));
    const float mc = m * C2;
    float lsum = 0.f;
#pragma unroll
    for (int kb = 0; kb < 8; ++kb)
#pragma unroll
        for (int r = 0; r < 16; ++r) { const float p = __builtin_amdgcn_exp2f(s[kb][r] * C2 - mc); s[kb][r] = p; lsum += p; }
    lsum += __shfl_xor(lsum, 32);
    __syncthreads();
    f32x16 o[4];
#pragma unroll
    for (int db = 0; db < 4; ++db)
#pragma unroll
        for (int i = 0; i < 16; ++i) o[db][i] = 0.f;
#pragma unroll
    for (int kb = 0; kb < 8; ++kb)
#pragma unroll
        for (int st = 0; st < 2; ++st) {
            u32x4 pw;
#pragma unroll
            for (int j = 0; j < 4; ++j) pw[j] = cvtpk(s[kb][8 * st + 2 * j], s[kb][8 * st + 2 * j + 1]);
            const bf16x8 pa = __builtin_bit_cast(bf16x8, pw);
            const int c = 4 * kb + 2 * st + hh;
#pragma unroll
            for (int db = 0; db < 4; ++db) {
                const int d = db * 32 + r32;
                const bf16x8 b = *(const LAS bf16x8*)(lds + 65536 + d * 512 + ((((c & 15) ^ (d & 15)) | (c & 16)) << 4));
                o[db] = __builtin_amdgcn_mfma_f32_32x32x16_bf16(pa, b, o[db], 0, 0, 0);
            }
        }
    LAS float* lsc = (LAS float*)(lds + XSCR_OFF + wid * 128);
    if (hh == 0) lsc[r32] = lsum;
    asm volatile("s_waitcnt lgkmcnt(0)" ::: "memory");
    LAS bf16* stg = (LAS bf16*)(lds + wid * 8192);
#pragma unroll
    for (int r = 0; r < 16; ++r) {
        const int q = crow(r, hh); const float rl = 1.0f / lsc[q];
#pragma unroll
        for (int db = 0; db < 4; ++db) stg[q * 128 + db * 32 + r32] = (bf16)f2bf(o[db][r] * rl);
    }
    asm volatile("s_waitcnt lgkmcnt(0)" ::: "memory");
#pragma unroll
    for (int i = 0; i < 8; ++i) {
        const int idx = i * 64 + lane, row = idx >> 4, ch = idx & 15;
        const u32x4 ov = *(const LAS u32x4*)(stg + row * 128 + ch * 8);
        const size_t grow = (size_t)(row0 + wid * 32 + row);
        const u32x4 gv = *(const GAS u32x4*)(gsrc + grow * gld + ch * 8);
        u32x4 w;
#pragma unroll
        for (int j = 0; j < 4; ++j) w[j] = pk2(bflo(ov[j]) * silu(bflo(gv[j])), bfhi(ov[j]) * silu(bfhi(gv[j])));
        *(GAS u32x4*)(yd + grow * yld + ch * 8) = w;
    }
    __syncthreads();
}
}

__device__ __forceinline__ void phase_img(const bf16* MKV, unsigned char* KIMG, unsigned char* VTIMG, int gt, int NGT) {
    for (int it = gt; it < 40 * 4096; it += NGT) {
        const int img = it >> 12, key = (it >> 4) & 255, c = it & 15, ls = img >> 2, h = img & 3;
        const v4u v = *(const GAS v4u*)(MKV + ((size_t)ls * 256 + key) * DM + h * 128 + c * 8);
        *(GAS v4u*)(KIMG + (size_t)img * 65536 + key * 256 + ((c ^ (key & 15)) << 4)) = v;
    }
    for (int it = gt; it < 40 * 4096; it += NGT) {
        const int img = it >> 12, d = (it >> 5) & 127, c = it & 31, ls = img >> 2, h = img & 3;
        const bf16* vsrc = MKV + (size_t)ls * 256 * DM + 512 + h * 128 + d;
        unsigned short e[8];
#pragma unroll
        for (int j = 0; j < 8; ++j) { const int p = c * 8 + j, key = (p & ~15) + xa::pos2key16(p & 15); e[j] = vsrc[(size_t)key * DM]; }
        v4u v; v.x = e[0] | ((unsigned)e[1] << 16); v.y = e[2] | ((unsigned)e[3] << 16); v.z = e[4] | ((unsigned)e[5] << 16); v.w = e[6] | ((unsigned)e[7] << 16);
        *(GAS v4u*)(VTIMG + (size_t)img * 65536 + d * 512 + ((((c & 15) ^ (d & 15)) | (c & 16)) << 4)) = v;
    }
}
namespace na {
typedef short bf16x8 __attribute__((ext_vector_type(8)));
typedef short s16x4 __attribute__((ext_vector_type(4)));
typedef float f32x4 __attribute__((ext_vector_type(4)));
typedef unsigned u32x4 __attribute__((ext_vector_type(4)));
constexpr int V_OFF = 61440, RPB_OFF = RING_BYTES + 2048, STG_OFF = RING_BYTES + 4096;
constexpr float LOG2E = 1.4426950408889634f, QS = 0.125f * LOG2E;
__device__ __forceinline__ int clampi(int v, int lo, int hi) { return v < lo ? lo : (v > hi ? hi : v); }
__device__ __forceinline__ s16x4 vtr(unsigned addr) { return __builtin_bit_cast(s16x4, __builtin_amdgcn_ds_read_tr16_b64_v4i16((LAS s16x4*)addr)); }

__device__ __forceinline__ void na_unit(LAS unsigned char* lds, const bf16* z, bf16* y, const float* rpb_h, int seqstart, int rows, int band, int cb, int h, int tid) {
    const int lane = tid & 63, wid = __builtin_amdgcn_readfirstlane(tid >> 6), l16 = lane & 15, g = lane >> 4;
    const int r = band * 8 + wid;
    const int lo = clampi(band * 8 - 4, 0, rows - 15), r0 = clampi(r - 4, 0, rows - 8), kstart = clampi(16 * cb - 8, 0, 32);
    if (tid < 465) ((LAS float*)(lds + RPB_OFF))[tid] = rpb_h[tid] * LOG2E;
    { const int half = wid >> 2, key8 = lane >> 3, cp = lane & 7;
      const bf16* zb = z + (size_t)(seqstart + lo * 64 + kstart) * INW + (half ? ZV : ZK) + h * 64;
#pragma unroll
      for (int j = 0; j < 15; ++j) {
          const int pp = (wid & 3) * 15 + j, a15 = pp >> 2, key = (pp & 3) * 8 + key8, sw = key >> 1;
          const int c = half ? ((((cp >> 1) ^ (sw & 3)) << 1) | (cp & 1)) : (cp ^ (sw & 7));
          __builtin_amdgcn_global_load_lds((const GAS unsigned*)(zb + (size_t)(a15 * 64 + key) * INW + c * 8), (LAS unsigned*)(lds + half * V_OFF + pp * 1024), 16, 0, 0);
      } }
    const size_t qtok = (size_t)(seqstart + r * 64 + cb * 16 + l16);
    const bf16x8 qf0 = *(const GAS bf16x8*)(z + qtok * INW + ZQ + h * 64 + g * 8), qf1 = *(const GAS bf16x8*)(z + qtok * INW + ZQ + h * 64 + 32 + g * 8);
    const int qcol = cb * 16 + l16, cs = clampi(qcol - 8, 0, 48), dyb = r0 - r + 7;
    int dxo[8]; bool vld[8];
#pragma unroll
    for (int e = 0; e < 8; ++e) { const int kcol = kstart + 16 * (e >> 2) + 4 * g + (e & 3); vld[e] = (kcol >= cs) && (kcol < cs + 16); dxo[e] = clampi(kcol - qcol + 15, 0, 30); }
    asm volatile("s_waitcnt vmcnt(0)" ::: "memory");
    __syncthreads();
    const int slot0 = r0 - lo;
    f32x4 s[8][2];
#pragma unroll
    for (int a = 0; a < 8; ++a)
#pragma unroll
        for (int cbk = 0; cbk < 2; ++cbk) {
            const int key = 16 * cbk + l16, sw = (key >> 1) & 7;
            LAS unsigned char* kb = lds + (slot0 + a) * 4096 + key * 128;
            const bf16x8 a0 = *(const LAS bf16x8*)(kb + ((g ^ sw) << 4)), a1 = *(const LAS bf16x8*)(kb + (((4 + g) ^ sw) << 4));
            f32x4 acc = (f32x4){0.f, 0.f, 0.f, 0.f};
            acc = __builtin_amdgcn_mfma_f32_16x16x32_bf16(a0, qf0, acc, 0, 0, 0);
            acc = __builtin_amdgcn_mfma_f32_16x16x32_bf16(a1, qf1, acc, 0, 0, 0);
            s[a][cbk] = acc;
        }
    const LAS float* rp = (const LAS float*)(lds + RPB_OFF);
    float m = -INFINITY;
#pragma unroll
    for (int a = 0; a < 8; ++a)
#pragma unroll
        for (int e = 0; e < 8; ++e) {
            float t = s[a][e >> 2][e & 3] * QS + rp[(a + dyb) * 31 + dxo[e]];
            t = vld[e] ? t : -INFINITY;
            s[a][e >> 2][e & 3] = t; m = fmaxf(m, t);
        }
    m = fmaxf(m, __shfl_xor(m, 16)); m = fmaxf(m, __shfl_xor(m, 32));
    float lsum = 0.f;
#pragma unroll
    for (int a = 0; a < 8; ++a)
#pragma unroll
        for (int e = 0; e < 8; ++e) { const float p = __builtin_amdgcn_exp2f(s[a][e >> 2][e & 3] - m); s[a][e >> 2][e & 3] = p; lsum += p; }
    lsum += __shfl_xor(lsum, 16); lsum += __shfl_xor(lsum, 32);
    f32x4 o[4];
#pragma unroll
    for (int db = 0; db < 4; ++db) o[db] = (f32x4){0.f, 0.f, 0.f, 0.f};
    const int qq = l16 >> 2, pq = l16 & 3, klo = 4 * g + qq;
    const unsigned vlane = (unsigned)(uintptr_t)(lds + V_OFF) + klo * 128 + 8 * pq;
    const int vsw = (klo >> 1) & 3;
#pragma unroll
    for (int a = 0; a < 8; ++a) {
        u32x4 pw; pw[0] = xa::cvtpk(s[a][0][0], s[a][0][1]); pw[1] = xa::cvtpk(s[a][0][2], s[a][0][3]); pw[2] = xa::cvtpk(s[a][1][0], s[a][1][1]); pw[3] = xa::cvtpk(s[a][1][2], s[a][1][3]);
        const bf16x8 pa = __builtin_bit_cast(bf16x8, pw);
        const unsigned vb = vlane + (slot0 + a) * 4096;
#pragma unroll
        for (int db = 0; db < 4; ++db) {
            const s16x4 vl = vtr(vb + ((db ^ vsw) << 5)), vh = vtr(vb + 2048 + ((db ^ vsw) << 5));
            const bf16x8 b = (bf16x8){vl[0], vl[1], vl[2], vl[3], vh[0], vh[1], vh[2], vh[3]};
            o[db] = __builtin_amdgcn_mfma_f32_16x16x32_bf16(pa, b, o[db], 0, 0, 0);
        }
    }
    float rl[4];
#pragma unroll
    for (int i = 0; i < 4; ++i) rl[i] = 1.0f / __shfl(lsum, 4 * g + i);
    LAS bf16* stg = (LAS bf16*)(lds + STG_OFF + wid * 2048);
#pragma unroll
    for (int db = 0; db < 4; ++db)
#pragma unroll
        for (int i = 0; i < 4; ++i) stg[(4 * g + i) * 64 + 16 * db + l16] = (bf16)f2bf(o[db][i] * rl[i]);
    asm volatile("s_waitcnt lgkmcnt(0)" ::: "memory");
#pragma unroll
    for (int i2 = 0; i2 < 2; ++i2) {
        const int idx = i2 * 64 + lane, q = idx >> 3, ch = idx & 7;
        const u32x4 ov = *(const LAS u32x4*)(stg + q * 64 + ch * 8);
        const size_t tok = (size_t)(seqstart + r * 64 + cb * 16 + q);
        const u32x4 gv = *(const GAS u32x4*)(z + tok * INW + ZG + h * 64 + ch * 8);
        u32x4 w;
#pragma unroll
        for (int j = 0; j < 4; ++j) w[j] = pk2(bflo(ov[j]) * silu(bflo(gv[j])), bfhi(ov[j]) * silu(bfhi(gv[j])));
        *(GAS u32x4*)(y + tok * BRW + h * 64 + ch * 8) = w;
    }
    __syncthreads();
}
}
struct Args { const float* in[13]; float* out; unsigned char* ws; int ph_lo, ph_hi; };
__global__ void __launch_bounds__(NWAVES * 64, 2) fwd_kernel(Args args) {
    extern __shared__ __attribute__((aligned(16))) unsigned char lds_raw[];
    LAS unsigned char* lds = (LAS unsigned char*)lds_raw;
    volatile LAS unsigned* MISC = (volatile LAS unsigned*)(lds + MISC_OFF);
#define KARG(off) karg64<(off)>()
#define LOAD_PTRS() Ptrs P; do { unsigned char* ws_ = (unsigned char*)(GAS unsigned char*)KARG(112); \
    P.xp = (const float*)(const GAS float*)KARG(0); P.xs = (const float*)(const GAS float*)KARG(8); P.memp = (const float*)(const GAS float*)KARG(16); P.mems = (const float*)(const GAS float*)KARG(24); P.norm_w = (const float*)(const GAS float*)KARG(32); \
    P.w_in = (const float*)(const GAS float*)KARG(40); P.w_out = (const float*)(const GAS float*)KARG(48); P.mem_norm_w = (const float*)(const GAS float*)KARG(56); P.w_mem_kv = (const float*)(const GAS float*)KARG(64); P.conv_w = (const float*)(const GAS float*)KARG(72); \
    P.conv_b = (const float*)(const GAS float*)KARG(80); P.na_rpb = (const float*)(const GAS float*)KARG(88); P.final_norm_w = (const float*)(const GAS float*)KARG(96); P.out = (float*)(GAS float*)KARG(104); \
    P.W1T = (bf16*)(ws_ + WS_W1T); P.W2T = (bf16*)(ws_ + WS_W2T); P.WKVT = (bf16*)(ws_ + WS_WKVT); P.MEMN = (bf16*)(ws_ + WS_MEMN); P.MKV = (bf16*)(ws_ + WS_MKV); \
    P.HB = (bf16*)(ws_ + WS_HB); P.Y = (bf16*)(ws_ + WS_Y); P.Z = (bf16*)(ws_ + WS_Z); P.KIMG = ws_ + WS_KIMG; P.VTIMG = ws_ + WS_VTIMG; P.YF = (bf16*)(ws_ + WS_YF); P.ZX = (bf16*)(ws_ + WS_ZX); P.EDGE = (float*)(ws_ + WS_EDGE); } while (0)
    for (int u = threadIdx.x; u < (LDS_BYTES - LDSCTL_OFF) / 4; u += NWAVES * 64) ((LAS unsigned*)(lds + LDSCTL_OFF))[u] = 0u;
    __syncthreads();
    const int lo = args.ph_lo, hi = args.ph_hi;
    if (hi - lo > 1) (void)xcd_barrier_post((unsigned*)((gu32*)((GAS unsigned char*)KARG(112) + WS_CTL) + CW_BAR), MISC + 8);

    for (int ph = lo; ph < hi; ++ph) {
        int tid = threadIdx.x; asm volatile("" : "+v"(tid));
        int bx = blockIdx.x; asm volatile("" : "+s"(bx));
        int G = gridDim.x; asm volatile("" : "+s"(G));
        const int lane = tid & 63, wave = __builtin_amdgcn_readfirstlane(tid >> 6);
        const int vcu = (G % 8 == 0) ? (bx % 8) * (G / 8) + bx / 8 : bx;
        const int gw = vcu * NWAVES + wave, NGW = G * NWAVES;
        const int gt = vcu * (NWAVES * 64) + tid, NGT = G * NWAVES * 64;
        LOAD_PTRS();
        if (ph == PH_PREP) {
            phase_prep(P, lds, gw, NGW, wave, lane);
        } else if (ph == PH_MKV) {
            for (int l = 0; l < 2; ++l) {
                pg8::Gemm g{P.MEMN + (size_t)l * MEMROWS * DM, P.WKVT + (size_t)l * DM * DM, MEMROWS, DM, DM};
                pg8::StaticOrder S; S.init(MEMROWS, DM, G, (bx + 128 * l) % G);
                pg8::EpiBf16<0> E{P.MKV + (size_t)l * MEMROWS * DM, DM, nullptr, 0, 0, 1.f};
                pg8::gemm_phase<pg8::EpiBf16<0>, pg8::StaticOrder, true, true>(lds + RING_OFF, g, S, E, tid);
            }
        } else if (ph == PH_IMG) {
            phase_img(P.MKV, P.KIMG, P.VTIMG, gt, NGT);
        } else if (ph == PH_G1_0) {
            pg8::Gemm g{P.HB, P.W1T, TOK, INW, DM};
            pg8::StaticOrder S; S.init(TOK, INW, G, bx);
            pg8::EpiConv E{P.YF, P.ZX, P.EDGE, P.conv_w, P.conv_b, lds + XL_OFF};
            pg8::gemm_phase<pg8::EpiConv, pg8::StaticOrder, true, true>(lds + RING_OFF, g, S, E, tid);
        } else if (ph == PH_MIX_0) {
            phase_edgefix(P, gt, NGT);
            for (int u = vcu; u < (TOK / 256) * XH; u += G) {
                const int pm = u >> 2, h = u & 3, grow = pm * 256, seq = (grow < 32768) ? (grow >> 13) : 4, img = seq * 4 + h;
                xa::xattn_unit(lds, P.ZX + h * 128, 1024, P.ZX + 512 + h * 128, 1024, P.YF + MIXW + h * 128, BRW, grow, P.KIMG + (size_t)img * 65536, P.VTIMG + (size_t)img * 65536, tid);
            }
        } else if (ph == PH_G2_0) {
            pg8::Gemm g{P.YF, P.W2T, TOK, DM, BRW};
            pg8::StaticOrder S; S.init(TOK, DM, G, bx);
            pg8::EpiRes2 E{P.xp, P.xs, P.out, 128};
            pg8::gemm_phase<pg8::EpiRes2, pg8::StaticOrder, true, true>(lds + RING_OFF, g, S, E, tid);
        } else if (ph == PH_NORM_0) {
            for (int m = gw; m < TOK; m += NGW) rms_row_to_bf16(P.out + (size_t)m * DM, P.norm_w + DM, P.HB + (size_t)m * DM, lane);
        } else if (ph == PH_NORM_1) {
            for (int m = gw; m < TOK; m += NGW) rms_row_to_f32(P.out + (size_t)m * DM, P.final_norm_w, P.out + (size_t)m * DM, lane);
        } else {
            const int r = ph - PH_L1, chunk = r / 3, kind = r % 3;
            if (kind == 0) {
                pg8::Gemm g{P.HB + (size_t)chunk * CH * DM, P.W1T + (size_t)INW * DM, CH, INW, DM};
                pg8::StaticOrder S; S.init(CH, INW, G, bx);
                pg8::EpiBf16<0> E{P.Z, INW, nullptr, 0, 0, 1.f};
                pg8::gemm_phase<pg8::EpiBf16<0>, pg8::StaticOrder, true, true>(lds + RING_OFF, g, S, E, tid);
            } else if (kind == 1) {
                const int seqlen = (chunk == 2) ? 16384 : 8192, rows = seqlen / 64, bps = rows / 8;
                for (int u = vcu; u < 32 * NAH * 4; u += G) {
                    const int cb = u & 3, h = (u >> 2) % NAH, b32 = (u >> 2) / NAH;
                    na::na_unit(lds, P.Z, P.Y, P.na_rpb + h * 465, (b32 / bps) * seqlen, rows, b32 % bps, cb, h, tid);
                }
                for (int u = vcu; u < (CH / 256) * XH; u += G) {
                    const int pm = u >> 2, h = u & 3, grow = chunk * CH + pm * 256, seq = (grow < 32768) ? (grow >> 13) : 4, img = (5 + seq) * 4 + h;
                    xa::xattn_unit(lds, P.Z + ZQM + h * 128, INW, P.Z + ZG + MIXW + h * 128, INW, P.Y + MIXW + h * 128, BRW, pm * 256, P.KIMG + (size_t)img * 65536, P.VTIMG + (size_t)img * 65536, tid);
                }
            } else {
                pg8::Gemm g{P.Y, P.W2T + (size_t)DM * BRW, CH, DM, BRW};
                pg8::StaticOrder S; S.init(CH, DM, G, bx);
                pg8::EpiResF32 E{P.out + (size_t)chunk * CH * DM, P.out + (size_t)chunk * CH * DM, DM};
                pg8::gemm_phase<pg8::EpiResF32, pg8::StaticOrder, true, true>(lds + RING_OFF, g, S, E, tid);
            }
        }
        if (ph + 1 < hi) { XcdBarrier bar; bar.bar = (unsigned*)((gu32*)((GAS unsigned char*)KARG(112) + WS_CTL) + CW_BAR); bar.x = xb_xcc_id(); bar.st = MISC + 8; xcd_barrier(bar); }
    }
}

extern "C" void kernel_launch(void* const* d_in, const int* in_sizes, int n_in, void* d_out, int out_size, void* d_ws, size_t ws_size, hipStream_t stream) {
    static int grid = 0;
    if (grid == 0) {
        if (n_in != 13 || out_size != TOK * DM || ws_size < WS_END) { fprintf(stderr, "kernel_launch: unexpected shapes (n_in %d out %d ws %zu)\n", n_in, out_size, ws_size); grid = -1; return; }
        int dev = 0, cus = 0, per_cu = 0;
        if (hipGetDevice(&dev) != hipSuccess || hipDeviceGetAttribute(&cus, hipDeviceAttributeMultiprocessorCount, dev) != hipSuccess) { grid = -1; return; }
        if (hipFuncSetAttribute((const void*)fwd_kernel, hipFuncAttributeMaxDynamicSharedMemorySize, LDS_BYTES) != hipSuccess) { fprintf(stderr, "kernel_launch: hipFuncSetAttribute failed\n"); grid = -1; return; }
        if (hipOccupancyMaxActiveBlocksPerMultiprocessor(&per_cu, (const void*)fwd_kernel, NWAVES * 64, LDS_BYTES) != hipSuccess || per_cu < 1) { fprintf(stderr, "kernel_launch: occupancy query says %d\n", per_cu); per_cu = 1; }
        (void)hipGetLastError();
        grid = cus;
    }
    if (grid < 0) return;
    (void)hipMemsetAsync((char*)d_ws + WS_CTL, 0, CTL_ZERO_BYTES, stream);
    Args a{};
    for (int i = 0; i < 13; ++i) a.in[i] = (const float*)d_in[i];
    a.out = (float*)d_out; a.ws = (unsigned char*)d_ws;
#if defined(PROBE_MODE)
    for (int ph = 0; ph < NPHASE; ++ph) {
        int reps = 1; const int r = ph - PH_L1, kind = r % 3;
        if (PROBE_MODE == 2 && ph == PH_G1_0) reps = PROBE_REPS;
        if (PROBE_MODE == 3 && ph == PH_MIX_0) reps = PROBE_REPS;
        if (PROBE_MODE == 4 && ph >= PH_L1 && ph < PH_NORM_1 && kind == 1) reps = PROBE_REPS;
        if (PROBE_MODE == 5 && ph == PH_G2_0) reps = PROBE_REPS;
        if (PROBE_MODE == 6 && (ph == PH_PREP || ph == PH_NORM_0)) reps = PROBE_REPS;
        if (PROBE_MODE == 7 && (ph == PH_MKV || ph == PH_IMG)) reps = PROBE_REPS;
        if (PROBE_MODE == 8 && ph >= PH_L1 && ph < PH_NORM_1 && kind == 0) reps = PROBE_REPS;
        for (int i = 0; i < reps; ++i) { a.ph_lo = ph; a.ph_hi = ph + 1; hipLaunchKernelGGL(fwd_kernel, dim3(grid), dim3(NWAVES * 64), LDS_BYTES, stream, a); }
    }
#elif MK_ONE_LAUNCH
    a.ph_lo = 0; a.ph_hi = NPHASE;
    hipLaunchKernelGGL(fwd_kernel, dim3(grid), dim3(NWAVES * 64), LDS_BYTES, stream, a);
#else
    for (int ph = 0; ph < NPHASE; ++ph) { a.ph_lo = ph; a.ph_hi = ph + 1;
        hipLaunchKernelGGL(fwd_kernel, dim3(grid), dim3(NWAVES * 64), LDS_BYTES, stream, a); }
#endif
}
```

```cpp
#include <hip/hip_runtime.h>
#include <cstdio>
#include <cstdint>
namespace pg8 {
#define PG8_LAS __attribute__((address_space(3)))
typedef unsigned short bf16_t;
typedef short bf16x8 __attribute__((ext_vector_type(8)));
typedef float f32x4 __attribute__((ext_vector_type(4)));
typedef unsigned u32x4 __attribute__((ext_vector_type(4)));
constexpr int BM = 256, BK = 64, HALF = 128, HTB = HALF * BK * 2  , STAGE_BYTES = 8 * HTB, NXCD = 8, WGM = 8;

__host__ __device__ __forceinline__ int lds_byte(int r, int c) { const int st = (r >> 4) * 2 + (c >> 5), rr = r & 15, cc = c & 31, ob = rr * 64 + cc * 2; return st * 1024 + (ob ^ (((ob >> 9) & 1) << 5)); }
__host__ __device__ __forceinline__ void stage_rc(int b, int& R, int& C) { const int st = b / 1024, sb = b % 1024, swz = sb ^ (((sb >> 9) & 1) << 5); R = (st >> 1) * 16 + swz / 64; C = (st & 1) * 32 + (swz % 64) / 2; }
__host__ __device__ __forceinline__ int perm32(int rho) { const int n = rho >> 4, i = rho & 15; return 8 * (i >> 2) + 4 * n + (i & 3); }

struct Unit { int pm, pn; };
struct Gemm { const bf16_t* A; const bf16_t* Bt; int M, N, K; };

struct StaticOrder {
    int nM, nN, nwg, G, c;
    __host__ __device__ void init(int M, int N, int G_, int c_) { nM = M / BM; nN = N / BM; nwg = nM * nN; G = G_; c = c_; }
    __host__ __device__ bool next(int i, Unit& u) const {
        const long L = (long)i * G + c; if (L >= nwg) return false;
        int wgid = (int)L; { const int q = nwg / NXCD, r = nwg % NXCD, xcd = wgid % NXCD, off = wgid / NXCD; wgid = (xcd < r ? xcd * (q + 1) : r * (q + 1) + (xcd - r) * q) + off; }
        const int nig = WGM * nN, gid = wgid / nig, fm = gid * WGM, gsz = (nM - fm) < WGM ? (nM - fm) : WGM;
        u.pm = fm + ((wgid % nig) % gsz); u.pn = (wgid % nig) / gsz; return true;
    }
    __device__ __forceinline__ void a_ready(const Unit&) const {}
    __device__ __forceinline__ void done(const Unit&) const {}
};

__device__ __forceinline__ unsigned cvt_pk_bf16(float lo, float hi) { unsigned r; asm volatile("v_cvt_pk_bf16_f32 %0, %1, %2" : "=v"(r) : "v"(lo), "v"(hi)); return r; }
typedef float f32x2 __attribute__((ext_vector_type(2)));
__device__ __forceinline__ f32x2 gelu_pk(f32x2 v) {
    const f32x2 av = __builtin_elementwise_abs(v), d = av * 0.2316418882f + 1.0f;
    f32x2 t; t.x = __builtin_amdgcn_rcpf(d.x); t.y = __builtin_amdgcn_rcpf(d.y);
    f32x2 q = t * 0.5307027145f + (-0.7265760135f); q = q * t + 0.7107068705f; q = q * t + (-0.142248368f); q = q * t + 0.127414796f; q = q * t;
    const f32x2 s = (v * v) * (-0.72134752044f);
    f32x2 e; e.x = __builtin_amdgcn_exp2f(s.x); e.y = __builtin_amdgcn_exp2f(s.y);
    const f32x2 m = v * (q * e), r = v - m;
    f32x2 o; o.x = v.x < 0.f ? m.x : r.x; o.y = v.y < 0.f ? m.y : r.y; return o;
}

template <int ACT  > struct EpiBf16 {
    static constexpr bool PERM = true, AFTER_DRAIN = false; static_assert(ACT == 0 || ACT == 1, "EpiBf16: ACT is 0 (none) or 1 (gelu_pk)");
    bf16_t* O; int ldc; const float* bias; int split_cols; size_t split_stride; float scale0;
    __device__ __forceinline__ void operator()(const f32x4 (&acc)[2][2][4][2], const Unit& u, int wr, int wc, int fr, int fq) const {
        const int row0 = u.pm * BM + wr * 64 + fr; int colt = u.pn * BM; bf16_t* base = O;
        float sc = 1.f; if (split_cols) { const int t = colt / split_cols; base += (size_t)t * split_stride; colt -= t * split_cols; if (t == 0) sc = scale0; }
        const int col0 = colt + wc * 32 + 8 * fq, bcol0 = u.pn * BM + wc * 32 + 8 * fq;
        f32x4 bv[2][2];
#pragma unroll
        for (int bj = 0; bj < 2; ++bj)
#pragma unroll
            for (int n = 0; n < 2; ++n) bv[bj][n] = bias ? *(const f32x4*)(bias + bcol0 + bj * HALF + 4 * n) : (f32x4){0.f, 0.f, 0.f, 0.f};
#pragma unroll
        for (int ai = 0; ai < 2; ++ai)
#pragma unroll
            for (int m = 0; m < 4; ++m) { bf16_t* rowp = base + (size_t)(row0 + ai * HALF + m * 16) * ldc + col0;
#pragma unroll
                for (int bj = 0; bj < 2; ++bj) { f32x4 v0 = acc[ai][bj][m][0] + bv[bj][0], v1 = acc[ai][bj][m][1] + bv[bj][1];
                    if (ACT == 1) { f32x2 a = gelu_pk((f32x2){v0[0], v0[1]}), b = gelu_pk((f32x2){v0[2], v0[3]}), c = gelu_pk((f32x2){v1[0], v1[1]}), d = gelu_pk((f32x2){v1[2], v1[3]});
                        v0 = (f32x4){a.x, a.y, b.x, b.y}; v1 = (f32x4){c.x, c.y, d.x, d.y}; }
                    v0 = v0 * sc; v1 = v1 * sc; u32x4 w; w.x = cvt_pk_bf16(v0[0], v0[1]); w.y = cvt_pk_bf16(v0[2], v0[3]); w.z = cvt_pk_bf16(v1[0], v1[1]); w.w = cvt_pk_bf16(v1[2], v1[3]);
                    *(u32x4*)(rowp + bj * HALF) = w; } }
    }
};
struct EpiResF32 {
    static constexpr bool PERM = false, AFTER_DRAIN = false;
    const float* base; float* out; int ldc;
    __device__ __forceinline__ void operator()(const f32x4 (&acc)[2][2][4][2], const Unit& u, int wr, int wc, int fr, int fq) const {
        const int row0 = u.pm * BM + wr * 64 + fr, col0 = u.pn * BM + wc * 32 + 4 * fq;
#pragma unroll
        for (int ai = 0; ai < 2; ++ai)
#pragma unroll
            for (int m = 0; m < 4; ++m) { const size_t off = (size_t)(row0 + ai * HALF + m * 16) * ldc + col0;
#pragma unroll
                for (int bj = 0; bj < 2; ++bj)
#pragma unroll
                    for (int n = 0; n < 2; ++n) { const f32x4 bs = *(const f32x4*)(base + off + bj * HALF + n * 16); *(f32x4*)(out + off + bj * HALF + n * 16) = bs + acc[ai][bj][m][n]; }
                if (m & 1) asm volatile("" ::: "memory"); }
    }
};
__host__ __device__ __forceinline__ int origcol0(int np) {
    const int tile = np >> 8, c = np & 255;
    if (tile < 24) { const int bj = c >> 7, wc = (c >> 5) & 3, n = (c >> 4) & 1, q = 2 * bj + n; const int qoff = (q == 0) ? 0 : (q == 1) ? 1536 : (q == 2) ? 3072 : 5120; return qoff + 64 * tile + 16 * wc + (c & 15); }
    const int zc = 256 * (tile - 24) + (c & ~31) + perm32(c & 31);
    return zc < 512 ? 4608 + zc : 6656 + (zc - 512);
}
template <int CTRL> __device__ __forceinline__ float dpp_f(float v) { return __builtin_bit_cast(float, __builtin_amdgcn_update_dpp(0, __builtin_bit_cast(int, v), CTRL, 0xf, 0xf, false)); }
__device__ __forceinline__ f32x4 ror1(f32x4 v) { return (f32x4){dpp_f<0x121>(v[0]), dpp_f<0x121>(v[1]), dpp_f<0x121>(v[2]), dpp_f<0x121>(v[3])}; }
__device__ __forceinline__ f32x4 ror15(f32x4 v) { return (f32x4){dpp_f<0x12f>(v[0]), dpp_f<0x12f>(v[1]), dpp_f<0x12f>(v[2]), dpp_f<0x12f>(v[3])}; }
__device__ __forceinline__ float silu_f(float g) { return g * __builtin_amdgcn_rcpf(1.0f + __builtin_amdgcn_exp2f(-1.4426950408889634f * g)); }
constexpr int EDGE_TILE_FLOATS = 2 * 3 * 1536;
struct EpiConv {
    static constexpr bool PERM = false, AFTER_DRAIN = false;
    bf16_t* Y; bf16_t* ZX; float* EDGE; const float* cw; const float* cb; PG8_LAS unsigned char* xl;
    __device__ __forceinline__ void operator()(const f32x4 (&acc)[2][2][4][2], const Unit& u, int wr, int wc, int fr, int fq) const {
        if (u.pn >= 24) {
            const int row0 = u.pm * BM + wr * 64 + fr, col0 = (u.pn - 24) * BM + wc * 32 + 8 * fq;
#pragma unroll
            for (int ai = 0; ai < 2; ++ai)
#pragma unroll
                for (int m = 0; m < 4; ++m) { bf16_t* rowp = ZX + (size_t)(row0 + ai * HALF + m * 16) * 1024 + col0;
#pragma unroll
                    for (int bj = 0; bj < 2; ++bj) { const f32x4 v0 = acc[ai][bj][m][0], v1 = acc[ai][bj][m][1];
                        u32x4 w; w.x = cvt_pk_bf16(v0[0], v0[1]); w.y = cvt_pk_bf16(v0[2], v0[3]); w.z = cvt_pk_bf16(v1[0], v1[1]); w.w = cvt_pk_bf16(v1[2], v1[3]);
                        *(u32x4*)(rowp + bj * HALF) = w; } }
            return;
        }
        const int lane = fq * 16 + fr, wid = wr * 4 + wc, chl = 16 * wc + 4 * fq, ch0 = 64 * u.pn + chl;
        const f32x4 w0 = *(const f32x4*)(cw + ch0), w1 = *(const f32x4*)(cw + 1536 + ch0), w2 = *(const f32x4*)(cw + 3072 + ch0), bb = *(const f32x4*)(cb + ch0);
        PG8_LAS float* xb = (PG8_LAS float*)(xl + 16384);
        f32x4 v[2][4];
#pragma unroll
        for (int ai = 0; ai < 2; ++ai) {
#pragma unroll
            for (int m = 0; m < 4; ++m) v[ai][m] = acc[ai][0][m][1] * acc[ai][1][m][0];
            const int blk = 2 * ai + wr;
            if (fr == 0) *(PG8_LAS f32x4*)(xb + (blk * 2 + 0) * 64 + chl) = v[ai][0];
            if (fr == 15) *(PG8_LAS f32x4*)(xb + (blk * 2 + 1) * 64 + chl) = v[ai][3];
        }
        asm volatile("s_waitcnt lgkmcnt(0)" ::: "memory"); __builtin_amdgcn_s_barrier(); asm volatile("" ::: "memory");
        const f32x4 zero4 = (f32x4){0.f, 0.f, 0.f, 0.f};
#pragma unroll
        for (int ai = 0; ai < 2; ++ai) {
            const int blk = 2 * ai + wr;
            f32x4 vprev = zero4, vnext = zero4;
            if (blk > 0) vprev = *(const PG8_LAS f32x4*)(xb + ((blk - 1) * 2 + 1) * 64 + chl);
            if (blk < 3) vnext = *(const PG8_LAS f32x4*)(xb + ((blk + 1) * 2 + 0) * 64 + chl);
#pragma unroll
            for (int m = 0; m < 4; ++m) {
                const f32x4 vc = v[ai][m];
                const f32x4 upa = ror1(vc), upb = (m > 0) ? ror1(v[ai][m > 0 ? m - 1 : 0]) : vprev;
                const f32x4 dna = ror15(vc), dnb = (m < 3) ? ror15(v[ai][m < 3 ? m + 1 : 3]) : vnext;
                const f32x4 up = (fr > 0) ? upa : upb, dn = (fr < 15) ? dna : dnb;
                const f32x4 conv = w0 * up + w1 * vc + w2 * dn + bb;
                const f32x4 p0 = acc[ai][0][m][0], gt = acc[ai][1][m][1];
                f32x4 pg, yv;
#pragma unroll
                for (int e = 0; e < 4; ++e) { pg[e] = p0[e] * silu_f(gt[e]); yv[e] = pg[e] * conv[e]; }
                if ((blk == 0 && m == 0 && fr == 0) || (blk == 3 && m == 3 && fr == 15)) {
                    float* eb = EDGE + (size_t)u.pm * EDGE_TILE_FLOATS + (blk == 0 ? 0 : 3 * 1536) + ch0;
                    *(f32x4*)(eb) = pg; *(f32x4*)(eb + 1536) = vc; *(f32x4*)(eb + 3072) = yv;
                }
                const int row = wr * 64 + m * 16 + fr;
                typedef unsigned u32x2 __attribute__((ext_vector_type(2)));
                u32x2 pk; pk.x = cvt_pk_bf16(yv[0], yv[1]); pk.y = cvt_pk_bf16(yv[2], yv[3]);
                *(PG8_LAS u32x2*)(xl + row * 128 + (((chl >> 2) ^ (row & 15)) << 3)) = pk;
            }
            asm volatile("s_waitcnt lgkmcnt(0)" ::: "memory"); __builtin_amdgcn_s_barrier(); asm volatile("" ::: "memory");
#pragma unroll
            for (int i = 0; i < 2; ++i) {
                const int idx = i * 512 + wid * 64 + lane, row = idx >> 3, c8 = idx & 7;
                u32x4 ov = *(const PG8_LAS u32x4*)(xl + row * 128 + (((2 * c8) ^ (row & 14)) << 3));
                if (row & 1) ov = (u32x4){ov.z, ov.w, ov.x, ov.y};
                *(u32x4*)(Y + (size_t)(u.pm * BM + ai * HALF + row) * 2048 + 64 * u.pn + c8 * 8) = ov;
            }
            if (ai == 0) { asm volatile("s_waitcnt lgkmcnt(0)" ::: "memory"); __builtin_amdgcn_s_barrier(); asm volatile("" ::: "memory"); }
        }
    }
};
__device__ __forceinline__ f32x4 ror8(f32x4 v) { return (f32x4){dpp_f<0x128>(v[0]), dpp_f<0x128>(v[1]), dpp_f<0x128>(v[2]), dpp_f<0x128>(v[3])}; }
struct EpiRes2 {
    static constexpr bool PERM = false, AFTER_DRAIN = false;
    const float* b0; const float* b1; float* out; int split_pm;
    __device__ __forceinline__ void operator()(const f32x4 (&acc)[2][2][4][2], const Unit& u, int wr, int wc, int fr, int fq) const {
        const bool hi = fr >= 8; const int r8 = fr & 7;
        const int row0 = u.pm * BM + wr * 64 + r8, col0 = u.pn * BM + wc * 32 + 4 * fq + (hi ? 16 : 0);
        const float* bsel = (u.pm < split_pm) ? b0 + (size_t)row0 * 1024 : b1 + (size_t)(row0 - split_pm * BM) * 1024;
        float* osel = out + (size_t)row0 * 1024;
#pragma unroll
        for (int ai = 0; ai < 2; ++ai)
#pragma unroll
            for (int m = 0; m < 4; ++m) { const size_t off = (size_t)(ai * HALF + m * 16) * 1024 + col0;
#pragma unroll
                for (int bj = 0; bj < 2; ++bj) {
                    const f32x4 a0 = acc[ai][bj][m][0], a1 = acc[ai][bj][m][1], x = ror8(a1), y = ror8(a0);
                    const f32x4 d1 = hi ? x : a0, d2 = hi ? a1 : y;
                    const f32x4 r1 = *(const f32x4*)(bsel + off + bj * HALF), r2 = *(const f32x4*)(bsel + off + bj * HALF + 8 * 1024);
                    *(f32x4*)(osel + off + bj * HALF) = r1 + d1; *(f32x4*)(osel + off + bj * HALF + 8 * 1024) = r2 + d2; }
                if (m & 1) asm volatile("" ::: "memory"); }
    }
};
template <class Epi, class Sched, bool ALIGN_EPI = false, bool SP2 = false>
__device__ __forceinline__ void gemm_phase(PG8_LAS unsigned char* lds, const Gemm g, const Sched& S, const Epi& E, const int tid) {
    const int wid = __builtin_amdgcn_readfirstlane(tid >> 6), lane = tid & 63, wr = wid >> 2, wc = wid & 3, fr = lane & 15, fq = lane >> 4;
    const int K = g.K, nt = K / BK;
    unsigned voffA[2], voffB[2];
#pragma unroll
    for (int i = 0; i < 2; ++i) { int R, C; stage_rc(tid * 16 + i * 8192, R, C); const int Rb = Epi::PERM ? ((R & ~31) + perm32(R & 31)) : R;
        voffA[i] = (unsigned)(R * K + C) * 2u; voffB[i] = (unsigned)(Rb * K + C) * 2u; }
    const size_t kstep = (size_t)(BK * 2);
    const size_t hstep = (size_t)HALF * K * 2;
    const size_t tstep = 2 * hstep;
    const unsigned ldsw = (unsigned)wid * 1024u;
    const int aoff = lds_byte(wr * 64 + fr, fq * 8), boff = lds_byte(wc * 32 + fr, fq * 8);
#define PG8_SA(b, h) (((b) * 2 + (h)) * HTB)
#define PG8_SB(b, h) ((4 + (b) * 2 + (h)) * HTB)
#define PG8_STAGE(bufoff, gbase, voff) do { _Pragma("unroll") for (int _i = 0; _i < 2; ++_i) \
        __builtin_amdgcn_global_load_lds((const unsigned*)((const char*)(gbase) + (voff)[_i]), (PG8_LAS unsigned*)(lds + (bufoff) + ldsw + _i * 8192), 16, 0, 0); } while (0)
#define PG8_LDA(dst, b, h) do { _Pragma("unroll") for (int m = 0; m < 4; ++m) _Pragma("unroll") for (int k = 0; k < 2; ++k) dst[m][k] = *(const PG8_LAS bf16x8*)(lds + PG8_SA(b, h) + aoff + m * 2048 + k * 1024); } while (0)
#define PG8_LDB(dst, b, h) do { _Pragma("unroll") for (int n = 0; n < 2; ++n) _Pragma("unroll") for (int k = 0; k < 2; ++k) dst[n][k] = *(const PG8_LAS bf16x8*)(lds + PG8_SB(b, h) + boff + n * 2048 + k * 1024); } while (0)
#define PG8_MMA(ai, bj, At, Bt) do { __builtin_amdgcn_s_setprio(1); _Pragma("unroll") for (int m = 0; m < 4; ++m) _Pragma("unroll") for (int n = 0; n < 2; ++n) _Pragma("unroll") for (int k = 0; k < 2; ++k) \
        acc[ai][bj][m][n] = __builtin_amdgcn_mfma_f32_16x16x32_bf16(Bt[n][k], At[m][k], acc[ai][bj][m][n], 0, 0, 0); __builtin_amdgcn_s_setprio(0); } while (0)
#define PG8_WAIT_V(n) asm volatile("s_waitcnt vmcnt(" #n ")" ::: "memory")
#define PG8_WAIT_L(n) asm volatile("s_waitcnt lgkmcnt(" #n ")" ::: "memory")
#define PG8_BAR __builtin_amdgcn_s_barrier()
#define PG8_SCHED __builtin_amdgcn_sched_barrier(0)
    Unit cur, nxt; int ui = 0;
    if (!S.next(0, cur)) return;
    f32x4 acc[2][2][4][2];
#pragma unroll
    for (int a = 0; a < 2; ++a)
#pragma unroll
        for (int b = 0; b < 2; ++b)
#pragma unroll
            for (int m = 0; m < 4; ++m)
#pragma unroll
                for (int n = 0; n < 2; ++n) acc[a][b][m][n] = (f32x4){0.f, 0.f, 0.f, 0.f};
    bf16x8 At[4][2], B0[2][2], B1[2][2];
    const char* cA = (const char*)g.A + (size_t)cur.pm * tstep; const char* cB = (const char*)g.Bt + (size_t)cur.pn * tstep;
    S.a_ready(cur);
    if constexpr (SP2) {
        PG8_STAGE(PG8_SB(0, 0), cB, voffB); PG8_STAGE(PG8_SB(0, 1), cB + hstep, voffB); PG8_STAGE(PG8_SA(0, 0), cA, voffA); PG8_STAGE(PG8_SA(0, 1), cA + hstep, voffA);
        if (wr == 1) PG8_BAR;
        PG8_WAIT_V(2); PG8_BAR;
        PG8_STAGE(PG8_SB(1, 0), cB + kstep, voffB); PG8_STAGE(PG8_SA(1, 0), cA + kstep, voffA); PG8_STAGE(PG8_SB(1, 1), cB + hstep + kstep, voffB);
        PG8_WAIT_V(6); PG8_BAR;
    } else {
        PG8_STAGE(PG8_SB(0, 0), cB, voffB); PG8_STAGE(PG8_SA(0, 0), cA, voffA); PG8_STAGE(PG8_SB(0, 1), cB + hstep, voffB); PG8_STAGE(PG8_SA(0, 1), cA + hstep, voffA);
        if (wr == 1) PG8_BAR;
        PG8_WAIT_V(4); PG8_BAR;
        PG8_STAGE(PG8_SB(1, 0), cB + kstep, voffB); PG8_STAGE(PG8_SA(1, 0), cA + kstep, voffA); PG8_STAGE(PG8_SB(1, 1), cB + hstep + kstep, voffB);
        PG8_WAIT_V(6); PG8_BAR;
    }
    for (;;) {
        const bool has_next = S.next(ui + 1, nxt);
        const char* nA = has_next ? (const char*)g.A + (size_t)nxt.pm * tstep : cA; const char* nB = has_next ? (const char*)g.Bt + (size_t)nxt.pn * tstep : cB;
        for (int t = 0; t < nt; t += 2) {
            const bool last = (t == nt - 2);
            const char* a1 = cA + (size_t)(t + 1) * kstep;
            const char* a2 = last ? nA : cA + (size_t)(t + 2) * kstep; const char* b2 = last ? nB : cB + (size_t)(t + 2) * kstep;
            const char* a3 = a2 + kstep; const char* b3 = b2 + kstep;
            if (last && has_next) S.a_ready(nxt);
            if constexpr (SP2) {
            PG8_LDB(B0, 0, 0); PG8_LDB(B1, 0, 1); PG8_SCHED; PG8_LDA(At, 0, 0); PG8_STAGE(PG8_SA(1, 1), a1 + hstep, voffA);
            PG8_WAIT_V(8); PG8_WAIT_L(0); PG8_BAR; PG8_MMA(0, 0, At, B0); PG8_MMA(0, 1, At, B1); PG8_BAR; PG8_SCHED;
            PG8_LDA(At, 0, 1); PG8_STAGE(PG8_SB(0, 0), b2, voffB); PG8_STAGE(PG8_SB(0, 1), b2 + hstep, voffB); PG8_STAGE(PG8_SA(0, 0), a2, voffA);
            PG8_WAIT_V(8); PG8_WAIT_L(0); PG8_BAR; PG8_MMA(1, 0, At, B0); PG8_MMA(1, 1, At, B1); PG8_BAR; PG8_SCHED;
            PG8_LDB(B0, 1, 0); PG8_LDB(B1, 1, 1); PG8_SCHED; PG8_LDA(At, 1, 0); PG8_STAGE(PG8_SA(0, 1), a2 + hstep, voffA);
            PG8_WAIT_V(8); PG8_WAIT_L(0); PG8_BAR; PG8_MMA(0, 0, At, B0); PG8_MMA(0, 1, At, B1); PG8_BAR; PG8_SCHED;
            PG8_LDA(At, 1, 1); PG8_STAGE(PG8_SB(1, 0), b3, voffB); PG8_STAGE(PG8_SB(1, 1), b3 + hstep, voffB); PG8_STAGE(PG8_SA(1, 0), a3, voffA);
            PG8_WAIT_V(8); PG8_WAIT_L(0); PG8_BAR; PG8_MMA(1, 0, At, B0); PG8_MMA(1, 1, At, B1); PG8_BAR; PG8_SCHED;
            } else {
            PG8_LDB(B0, 0, 0); PG8_SCHED; PG8_LDA(At, 0, 0); PG8_STAGE(PG8_SA(1, 1), a1 + hstep, voffA);
            PG8_WAIT_L(8); PG8_BAR; PG8_WAIT_L(0); PG8_MMA(0, 0, At, B0); PG8_BAR; PG8_SCHED;
            PG8_LDB(B1, 0, 1); PG8_STAGE(PG8_SB(0, 0), b2, voffB);
            PG8_BAR; PG8_WAIT_L(0); PG8_MMA(0, 1, At, B1); PG8_BAR;
            PG8_LDA(At, 0, 1); PG8_STAGE(PG8_SA(0, 0), a2, voffA);
            PG8_BAR; PG8_WAIT_L(0); PG8_MMA(1, 0, At, B0); PG8_BAR; PG8_SCHED;
            PG8_STAGE(PG8_SB(0, 1), b2 + hstep, voffB);
            PG8_WAIT_V(6); PG8_BAR; PG8_MMA(1, 1, At, B1); PG8_BAR;
            PG8_LDB(B0, 1, 0); PG8_SCHED; PG8_LDA(At, 1, 0); PG8_STAGE(PG8_SA(0, 1), a2 + hstep, voffA);
            PG8_WAIT_L(8); PG8_BAR; PG8_WAIT_L(0); PG8_MMA(0, 0, At, B0); PG8_BAR; PG8_SCHED;
            PG8_LDB(B1, 1, 1); PG8_STAGE(PG8_SB(1, 0), b3, voffB);
            PG8_BAR; PG8_WAIT_L(0); PG8_MMA(0, 1, At, B1); PG8_BAR;
            PG8_LDA(At, 1, 1); PG8_STAGE(PG8_SA(1, 0), a3, voffA);
            PG8_BAR; PG8_WAIT_L(0); PG8_MMA(1, 0, At, B0); PG8_BAR; PG8_SCHED;
            PG8_STAGE(PG8_SB(1, 1), b3 + hstep, voffB);
            PG8_WAIT_V(6); PG8_BAR; PG8_MMA(1, 1, At, B1); PG8_BAR;
            }
        }
        if constexpr (ALIGN_EPI) { if (wr == 0) PG8_BAR; }
        if constexpr (!Epi::AFTER_DRAIN) { E(acc, cur, wr, wc, fr, fq); S.done(cur); }
        if (!has_next) break;
#pragma unroll
        for (int a = 0; a < 2; ++a)
#pragma unroll
            for (int b = 0; b < 2; ++b)
#pragma unroll
                for (int m = 0; m < 4; ++m)
#pragma unroll
                    for (int n = 0; n < 2; ++n) acc[a][b][m][n] = (f32x4){0.f, 0.f, 0.f, 0.f};
        cur = nxt; cA = nA; cB = nB; ++ui;
        if constexpr (ALIGN_EPI) { if (wr == 1) PG8_BAR; }
    }
    PG8_WAIT_V(0);
    if constexpr (!ALIGN_EPI) { if (wr == 0) PG8_BAR; }
    PG8_BAR;
    if constexpr (Epi::AFTER_DRAIN) { E.fused(acc, cur, wr, wc, fr, fq, lds, wid, lane); S.done(cur); }
#undef PG8_SA
#undef PG8_SB
#undef PG8_STAGE
#undef PG8_LDA
#undef PG8_LDB
#undef PG8_MMA
#undef PG8_WAIT_V
#undef PG8_WAIT_L
#undef PG8_BAR
#undef PG8_SCHED
}
}
#ifndef MK_ONE_LAUNCH
#define MK_ONE_LAUNCH 1
#endif
constexpr int NWAVES = 8;
constexpr int DM = 1024, INW = 7168, BRW = 2048, MIXW = 1536, XW = 512;
constexpr int TOK = 49152, CH = 16384, NCH = 3;
constexpr int MEMROWS = 1280;
constexpr int NAH = 24, XH = 4;
constexpr int ZQ = 0, ZK = 1536, ZV = 3072, ZQM = 4608, ZG = 5120;
constexpr float RMS_EPS = 1e-6f;
constexpr size_t MiB = 1u << 20;
constexpr size_t WS_CTL = 0, CTL_ZERO_BYTES = 1 * MiB;
constexpr size_t WS_W1T = 2 * MiB;
constexpr size_t WS_W2T = 30 * MiB;
constexpr size_t WS_WKVT = 38 * MiB;
constexpr size_t WS_MEMN = 42 * MiB;
constexpr size_t WS_MKV = 47 * MiB;
constexpr size_t WS_KIMG = 52 * MiB;
constexpr size_t WS_VTIMG = 55 * MiB;
constexpr size_t WS_EDGE = 58 * MiB;
constexpr size_t WS_HB = 66 * MiB;
constexpr size_t WS_A = 162 * MiB;
constexpr size_t WS_YF = WS_A, WS_ZX = WS_A + 192 * MiB, WS_Z = WS_A, WS_Y = WS_A + 224 * MiB;
constexpr size_t WS_END = 450 * MiB;
constexpr int CW_BAR = 4096;
constexpr int RING_OFF = 0, RING_BYTES = 131072;
constexpr int LDSCTL_OFF = RING_BYTES, MISC_OFF = LDSCTL_OFF + 320;
constexpr int LDS_BYTES = 163840;
constexpr int PH_PREP = 0, PH_MKV = 1, PH_IMG = 2, PH_G1_0 = 3, PH_MIX_0 = 4, PH_G2_0 = 5, PH_NORM_0 = 6, PH_L1 = 7, PH_NORM_1 = 16, NPHASE = 17;
constexpr int XL_OFF = RING_BYTES + 1024;

#define GAS __attribute__((address_space(1)))
#define LAS __attribute__((address_space(3)))
typedef unsigned short bf16;
typedef unsigned v4u __attribute__((ext_vector_type(4)));
typedef float f32x4 __attribute__((ext_vector_type(4)));
typedef GAS unsigned gu32;
#define RLX_AGENT __ATOMIC_RELAXED, __HIP_MEMORY_SCOPE_AGENT
#define LDS_WAIT() asm volatile("s_waitcnt lgkmcnt(0)" ::: "memory")
__device__ __forceinline__ unsigned f2bf(float f) { unsigned u = __builtin_bit_cast(unsigned, f); return (u + 0x7fffu + ((u >> 16) & 1u)) >> 16; }
__device__ __forceinline__ unsigned pk2(float lo, float hi) { return f2bf(lo) | (f2bf(hi) << 16); }
__device__ __forceinline__ float bf2f(unsigned short b) { return __uint_as_float((unsigned)b << 16); }
__device__ __forceinline__ float bflo(unsigned w) { return __uint_as_float(w << 16); }
__device__ __forceinline__ float bfhi(unsigned w) { return __uint_as_float(w & 0xffff0000u); }
__device__ __forceinline__ float silu(float g) { return g / (1.0f + __expf(-g)); }
__device__ __forceinline__ float wave_sum(float v) {
#pragma unroll
    for (int o = 1; o < 64; o <<= 1) v += __shfl_xor(v, o);
    return v;
}
__device__ __forceinline__ float wave_max(float v) {
#pragma unroll
    for (int o = 1; o < 64; o <<= 1) v = fmaxf(v, __shfl_xor(v, o));
    return v;
}
template <int OFF> __device__ __forceinline__ unsigned long long karg64() {
    unsigned long long v; auto ka = __builtin_amdgcn_kernarg_segment_ptr();
    asm volatile("s_load_dwordx2 %0, %1, %2\n\ts_waitcnt lgkmcnt(0)" : "=s"(v) : "s"(ka), "i"(OFF) : "memory");
    return v;
}
#define XB_TMO      128
#define XB_XCNT(j)  (256  + 64 * (j))
#define XB_XSUB(j)  (1280 + 64 * (j))
#define XB_XGEN(j)  (2304 + 64 * (j))
#define XB_TOP      3328
#define XB_TOPGEN   3392
#define XCD_BAR_WORDS 3456
#define XB_SPIN_CAP (1u << 18)

__device__ __forceinline__ unsigned xb_ld(unsigned* p)              { return __hip_atomic_load(p, __ATOMIC_RELAXED, __HIP_MEMORY_SCOPE_AGENT); }
__device__ __forceinline__ unsigned xb_add(unsigned* p, unsigned v) { return __hip_atomic_fetch_add(p, v, __ATOMIC_RELAXED, __HIP_MEMORY_SCOPE_AGENT); }
__device__ __forceinline__ unsigned xb_xcc_id() { return (unsigned)__builtin_amdgcn_s_getreg((3 << 11) | 20) & 0xFu; }
#define XB_SPIN(cond, bar) do { unsigned _sp = 0; while (cond) { __builtin_amdgcn_s_sleep(1); \
    if ((++_sp & 255u) == 0u) { if (xb_ld(&(bar)[XB_TMO])) break; if (_sp > XB_SPIN_CAP) { atomicAdd(&(bar)[XB_TMO], 1u); break; } } } } while (0)

struct XcdBarrier {
    unsigned* bar; unsigned x;
    volatile LAS unsigned* st;
};

__device__ __forceinline__ XcdBarrier xcd_barrier_post(unsigned* bar, volatile LAS unsigned* st) {
    XcdBarrier b; b.bar = bar; b.x = xb_xcc_id(); b.st = st;
    if (threadIdx.x == 0) (void)xb_add(&bar[XB_XCNT(b.x)], 1u);
    return b;
}
__device__ __forceinline__ void xcd_barrier_complete(unsigned* bar, unsigned x, unsigned& nloc, unsigned& nx) {
    const unsigned G = gridDim.x * gridDim.y * gridDim.z;
    unsigned sum, cnt, mine, sp = 0u;
    for (;;) {
        sum = 0u; cnt = 0u; mine = 0u;
#pragma unroll
        for (unsigned j = 0; j < 16; ++j) { const unsigned c = xb_ld(&bar[XB_XCNT(j)]); sum += c; cnt += (c > 0u) ? 1u : 0u; mine = (j == x) ? c : mine; }
        if (sum == G) break;
        __builtin_amdgcn_s_sleep(1);
        if ((++sp & 255u) == 0u) { if (xb_ld(&bar[XB_TMO])) break; if (sp > XB_SPIN_CAP) { atomicAdd(&bar[XB_TMO], 1u); break; } }
    }
    nloc = mine > 0u ? mine : 1u; nx = cnt > 0u ? cnt : 1u;
}

__device__ __forceinline__ void xcd_barrier(const XcdBarrier& b) {
    asm volatile("s_waitcnt vmcnt(0)" ::: "memory");
    __syncthreads();
    if (threadIdx.x == 0) {
        unsigned* bar = b.bar;
        __builtin_amdgcn_s_waitcnt(0);
        unsigned nloc = b.st[0], nx = b.st[1];
        if (nloc == 0u) { xcd_barrier_complete(bar, b.x, nloc, nx); b.st[0] = nloc; b.st[1] = nx; }
        const unsigned old = xb_add(&bar[XB_XSUB(b.x)], 1u);
        const unsigned gen = old / nloc;
        if (old + 1u == (gen + 1u) * nloc) {
            __builtin_amdgcn_fence(__ATOMIC_RELEASE, "agent");
            asm volatile("s_waitcnt vmcnt(0)" ::: "memory");
            const unsigned og = xb_add(&bar[XB_TOP], 1u);
            const unsigned tg = og / nx;
            if (og + 1u == (tg + 1u) * nx) xb_add(&bar[XB_TOPGEN], 1u);
            else XB_SPIN(xb_ld(&bar[XB_TOPGEN]) == tg, bar);
            __builtin_amdgcn_fence(__ATOMIC_ACQUIRE, "agent");
            xb_add(&bar[XB_XGEN(b.x)], 1u);
            asm volatile("s_waitcnt vmcnt(0)" ::: "memory");
        } else {
            XB_SPIN(xb_ld(&bar[XB_XGEN(b.x)]) == gen, bar);
            __builtin_amdgcn_fence(__ATOMIC_ACQUIRE, "agent");
            asm volatile("s_waitcnt vmcnt(0)" ::: "memory");
        }
    }
    __syncthreads();
}
template <bool MAP0> __device__ __forceinline__ void transpose_item(const float* W, int K, int N, bf16* WT, LAS float* scr, int item, int lane) {
    const int nblk = N / 32, kb = item / nblk, nb = item % nblk, k0 = 64 * kb, n0 = 32 * nb;
    const int csrc = MAP0 ? pg8::origcol0(n0 + (lane & 31)) : n0 + (lane & 31);
#pragma unroll 8
    for (int i = 0; i < 32; ++i) { const int kk = 2 * i + (lane >> 5); scr[kk * 33 + (lane & 31)] = W[(size_t)(k0 + kk) * N + csrc]; }
    LDS_WAIT(); asm volatile("" ::: "memory");
    const int c = lane & 7;
#pragma unroll
    for (int j = 0; j < 4; ++j) { const int n = (lane >> 3) + 8 * j; const LAS float* s = scr + (8 * c) * 33 + n;
        v4u o; o.x = pk2(s[0 * 33], s[1 * 33]); o.y = pk2(s[2 * 33], s[3 * 33]); o.z = pk2(s[4 * 33], s[5 * 33]); o.w = pk2(s[6 * 33], s[7 * 33]);
        *(GAS v4u*)(WT + (size_t)(n0 + n) * K + k0 + 8 * c) = o; }
    LDS_WAIT(); asm volatile("" ::: "memory");
}
__device__ __forceinline__ void rms_row_to_bf16(const float* xrow, const float* w, bf16* orow, int lane) {
    const GAS f32x4* xr = (const GAS f32x4*)xrow + lane; const GAS f32x4* wr = (const GAS f32x4*)w + lane;
    f32x4 v[4]; float s = 0.f;
#pragma unroll
    for (int j = 0; j < 4; ++j) { v[j] = xr[64 * j]; s += (v[j].x * v[j].x + v[j].y * v[j].y) + (v[j].z * v[j].z + v[j].w * v[j].w); }
    const float rstd = 1.f / sqrtf(wave_sum(s) * (1.f / DM) + RMS_EPS);
    GAS unsigned long long* o8 = (GAS unsigned long long*)orow + lane;
#pragma unroll
    for (int j = 0; j < 4; ++j) { const f32x4 ww = wr[64 * j];
        o8[64 * j] = (unsigned long long)pk2(v[j].x * rstd * ww.x, v[j].y * rstd * ww.y) | ((unsigned long long)pk2(v[j].z * rstd * ww.z, v[j].w * rstd * ww.w) << 32); }
}
__device__ __forceinline__ void rms_row_to_f32(const float* xrow, const float* w, float* orow, int lane) {
    const GAS f32x4* xr = (const GAS f32x4*)xrow + lane; const GAS f32x4* wr = (const GAS f32x4*)w + lane;
    f32x4 v[4]; float s = 0.f;
#pragma unroll
    for (int j = 0; j < 4; ++j) { v[j] = xr[64 * j]; s += (v[j].x * v[j].x + v[j].y * v[j].y) + (v[j].z * v[j].z + v[j].w * v[j].w); }
    const float rstd = 1.f / sqrtf(wave_sum(s) * (1.f / DM) + RMS_EPS);
    GAS f32x4* o = (GAS f32x4*)orow + lane;
#pragma unroll
    for (int j = 0; j < 4; ++j) { const f32x4 ww = wr[64 * j]; o[64 * j] = (v[j] * rstd) * ww; }
}

struct Ptrs {
    const float *xp, *xs, *memp, *mems, *norm_w, *w_in, *w_out, *mem_norm_w, *w_mem_kv, *conv_w, *conv_b, *na_rpb, *final_norm_w;
    float* out;
    bf16 *W1T, *W2T, *WKVT, *MEMN, *MKV, *HB, *Y, *Z;
    unsigned char *KIMG, *VTIMG;
    bf16 *YF, *ZX; float* EDGE;
};

__device__ __forceinline__ void phase_prep(const Ptrs& P, LAS unsigned char* lds, int gw, int NGW, int wave, int lane) {
    LAS float* scr = (LAS float*)(lds + RING_OFF + wave * 16384);
    constexpr int I_W1 = (DM / 64) * (INW / 32), I_W2 = (BRW / 64) * (DM / 32), I_KV = (DM / 64) * (DM / 32);
    constexpr int NITEMS = 2 * (I_W1 + I_W2 + I_KV);
    for (int it = gw; it < NITEMS; it += NGW) {
        int r = it;
        if (r < I_W1) { transpose_item<true>(P.w_in, DM, INW, P.W1T, scr, r, lane); continue; } r -= I_W1;
        if (r < I_W1) { transpose_item<false>(P.w_in + (size_t)DM * INW, DM, INW, P.W1T + (size_t)INW * DM, scr, r, lane); continue; } r -= I_W1;
        if (r < 2 * I_W2) { const int l = r / I_W2; transpose_item<false>(P.w_out + (size_t)l * BRW * DM, BRW, DM, P.W2T + (size_t)l * DM * BRW, scr, r % I_W2, lane); continue; } r -= 2 * I_W2;
        { const int l = r / I_KV; transpose_item<false>(P.w_mem_kv + (size_t)l * DM * DM, DM, DM, P.WKVT + (size_t)l * DM * DM, scr, r % I_KV, lane); }
    }
    for (int m = gw; m < 2 * MEMROWS; m += NGW) { const int l = m / MEMROWS, r = m % MEMROWS;
        const float* src = (r < 1024) ? P.memp + (size_t)r * DM : P.mems + (size_t)(r - 1024) * DM;
        rms_row_to_bf16(src, P.mem_norm_w + l * DM, P.MEMN + (size_t)m * DM, lane); }
    for (int m = gw; m < TOK; m += NGW) { const float* src = (m < 32768) ? P.xp + (size_t)m * DM : P.xs + (size_t)(m - 32768) * DM;
        rms_row_to_bf16(src, P.norm_w, P.HB + (size_t)m * DM, lane); }
}

__device__ __forceinline__ void phase_conv(const Ptrs& P, int chunk, int gt, int NGT) {
    const int seqlen = (chunk == 2) ? 16384 : 8192;
    const bf16* z = P.Z; bf16* y = P.Y;
    for (int it = gt; it < CH * (MIXW / 8); it += NGT) {
        const int tl = it / (MIXW / 8), cg = it % (MIXW / 8), ch = cg * 8;
        const int ts = tl % seqlen; const bool hp = ts > 0, hn = ts < seqlen - 1;
        const bf16* zr = z + (size_t)tl * INW + ch;
        const v4u p0 = *(const GAS v4u*)(zr + ZQ), p1 = *(const GAS v4u*)(zr + ZK), p2 = *(const GAS v4u*)(zr + ZV), gg = *(const GAS v4u*)(zr + ZG);
        v4u a1 = (v4u){0, 0, 0, 0}, a2 = a1, b1 = a1, b2 = a1;
        if (hp) { a1 = *(const GAS v4u*)(zr - INW + ZK); a2 = *(const GAS v4u*)(zr - INW + ZV); }
        if (hn) { b1 = *(const GAS v4u*)(zr + INW + ZK); b2 = *(const GAS v4u*)(zr + INW + ZV); }
        float cw0[8], cw1[8], cw2[8], cb[8];
#pragma unroll
        for (int j = 0; j < 8; ++j) { cw0[j] = P.conv_w[ch + j]; cw1[j] = P.conv_w[MIXW + ch + j]; cw2[j] = P.conv_w[2 * MIXW + ch + j]; cb[j] = P.conv_b[ch + j]; }
        v4u o;
#pragma unroll
        for (int w = 0; w < 4; ++w) {
            float r[2];
#pragma unroll
            for (int e = 0; e < 2; ++e) {
                const int j = 2 * w + e;
                const float vp = e ? bfhi(a1[w]) * bfhi(a2[w]) : bflo(a1[w]) * bflo(a2[w]);
                const float vc = e ? bfhi(p1[w]) * bfhi(p2[w]) : bflo(p1[w]) * bflo(p2[w]);
                const float vn = e ? bfhi(b1[w]) * bfhi(b2[w]) : bflo(b1[w]) * bflo(b2[w]);
                const float conv = vp * cw0[j] + vc * cw1[j] + vn * cw2[j] + cb[j];
                const float b = e ? bfhi(p0[w]) : bflo(p0[w]);
                const float g = e ? bfhi(gg[w]) : bflo(gg[w]);
                r[e] = b * conv * silu(g);
            }
            o[w] = pk2(r[0], r[1]);
        }
        *(GAS v4u*)(y + (size_t)tl * BRW + ch) = o;
    }
}

__device__ __forceinline__ void phase_na_naive(const Ptrs& P, int chunk, int gw, int NGW, int lane) {
    const int seqlen = (chunk == 2) ? 16384 : 8192; const int rows = seqlen / 64;
    const bf16* z = P.Z; bf16* y = P.Y; const float* rpb = P.na_rpb;
    for (int task = gw; task < CH * NAH; task += NGW) {
        const int tl = task / NAH, h = task % NAH;
        const int ss = (tl / seqlen) * seqlen, ts = tl - ss, r = ts >> 6, c = ts & 63;
        int r0 = r - 4; r0 = r0 < 0 ? 0 : (r0 > rows - 8 ? rows - 8 : r0);
        int c0 = c - 8; c0 = c0 < 0 ? 0 : (c0 > 48 ? 48 : c0);
        v4u qv[8];
        { const GAS v4u* qp = (const GAS v4u*)(z + (size_t)tl * INW + ZQ + h * 64);
#pragma unroll
          for (int i = 0; i < 8; ++i) qv[i] = qp[i]; }
        float lg[2];
#pragma unroll
        for (int u = 0; u < 2; ++u) {
            const int kk = lane + 64 * u, a = kk >> 4, j = kk & 15;
            const int kt = ss + (r0 + a) * 64 + c0 + j;
            const GAS v4u* kp = (const GAS v4u*)(z + (size_t)kt * INW + ZK + h * 64);
            float dot = 0.f;
#pragma unroll
            for (int i = 0; i < 8; ++i) { const v4u kv = kp[i];
#pragma unroll
                for (int w = 0; w < 4; ++w) dot += bflo(qv[i][w]) * bflo(kv[w]) + bfhi(qv[i][w]) * bfhi(kv[w]); }
            lg[u] = dot * 0.125f + rpb[(h * 15 + (r0 + a - r + 7)) * 31 + (c0 + j - c + 15)];
        }
        const float mx = wave_max(fmaxf(lg[0], lg[1]));
        float pe[2]; pe[0] = __expf(lg[0] - mx); pe[1] = __expf(lg[1] - mx);
        const float inv = 1.f / wave_sum(pe[0] + pe[1]);
        pe[0] *= inv; pe[1] *= inv;
        float o = 0.f;
#pragma unroll
        for (int u = 0; u < 2; ++u)
            for (int kl = 0; kl < 64; ++kl) {
                const float p = __shfl(pe[u], kl);
                const int kk = kl + 64 * u, a = kk >> 4, j = kk & 15;
                const int kt = ss + (r0 + a) * 64 + c0 + j;
                o += p * bf2f(z[(size_t)kt * INW + ZV + h * 64 + lane]);
            }
        const float g = bf2f(z[(size_t)tl * INW + ZG + h * 64 + lane]);
        y[(size_t)tl * BRW + h * 64 + lane] = (bf16)f2bf(o * silu(g));
    }
}

__device__ __forceinline__ void phase_xattn_naive(const Ptrs& P, int layer, int chunk, int gw, int NGW, int lane) {
    const bf16* z = P.Z; bf16* y = P.Y;
    for (int task = gw; task < CH * XH; task += NGW) {
        const int tl = task / XH, h = task % XH;
        const int g = chunk * CH + tl, s = (g < 32768) ? (g >> 13) : 4;
        const bf16* kb = P.MKV + ((size_t)layer * MEMROWS + s * 256) * DM + h * 128;
        const bf16* vb = kb + 512;
        v4u qv[16];
        { const GAS v4u* qp = (const GAS v4u*)(z + (size_t)tl * INW + ZQM + h * 128);
#pragma unroll
          for (int i = 0; i < 16; ++i) qv[i] = qp[i]; }
        float lg[4];
#pragma unroll
        for (int u = 0; u < 4; ++u) {
            const int key = lane + 64 * u;
            const GAS v4u* kp = (const GAS v4u*)(kb + (size_t)key * DM);
            float dot = 0.f;
#pragma unroll
            for (int i = 0; i < 16; ++i) { const v4u kv = kp[i];
#pragma unroll
                for (int w = 0; w < 4; ++w) dot += bflo(qv[i][w]) * bflo(kv[w]) + bfhi(qv[i][w]) * bfhi(kv[w]); }
            lg[u] = dot * 0.08838834764831845f;
        }
        const float mx = wave_max(fmaxf(fmaxf(lg[0], lg[1]), fmaxf(lg[2], lg[3])));
        float pe[4]; float sm = 0.f;
#pragma unroll
        for (int u = 0; u < 4; ++u) { pe[u] = __expf(lg[u] - mx); sm += pe[u]; }
        const float inv = 1.f / wave_sum(sm);
        float o0 = 0.f, o1 = 0.f;
#pragma unroll
        for (int u = 0; u < 4; ++u)
            for (int kl = 0; kl < 64; ++kl) {
                const float p = __shfl(pe[u], kl) * inv;
                const unsigned vv = *(const GAS unsigned*)(vb + (size_t)(kl + 64 * u) * DM + 2 * lane);
                o0 += p * bflo(vv); o1 += p * bfhi(vv);
            }
        const unsigned gg = *(const GAS unsigned*)(z + (size_t)tl * INW + ZG + MIXW + h * 128 + 2 * lane);
        *(GAS unsigned*)(y + (size_t)tl * BRW + MIXW + h * 128 + 2 * lane) = pk2(o0 * silu(bflo(gg)), o1 * silu(bfhi(gg)));
    }
}

__device__ __forceinline__ void phase_edgefix(const Ptrs& P, int gt, int NGT) {
    for (int it = gt; it < 192 * 2 * (MIXW / 4); it += NGT) {
        const int c4 = it % (MIXW / 4), tw = it / (MIXW / 4), which = tw & 1, pm = tw >> 1, ch = c4 * 4;
        const int t = pm * 256 + (which ? 255 : 0), tn = which ? t + 1 : t - 1;
        const bool has = which ? (tn < TOK && !((tn % 8192 == 0) && tn <= 32768)) : !((t % 8192 == 0) && t <= 32768);
        const float* eb = P.EDGE + (size_t)pm * pg8::EDGE_TILE_FLOATS + (which ? 3 * MIXW : 0) + ch;
        const f32x4 pg = *(const GAS f32x4*)(eb), yp = *(const GAS f32x4*)(eb + 2 * MIXW);
        f32x4 y = yp;
        if (has) { const int pn_ = which ? pm + 1 : pm - 1;
            const f32x4 vn = *(const GAS f32x4*)(P.EDGE + (size_t)pn_ * pg8::EDGE_TILE_FLOATS + (which ? 0 : 3 * MIXW) + MIXW + ch);
            const f32x4 w = *(const GAS f32x4*)(P.conv_w + (which ? 2 * MIXW : 0) + ch);
            y = yp + pg * w * vn; }
        typedef unsigned u32x2 __attribute__((ext_vector_type(2)));
        u32x2 o; o.x = pk2(y[0], y[1]); o.y = pk2(y[2], y[3]);
        *(GAS u32x2*)(P.YF + (size_t)t * BRW + ch) = o;
    }
}
namespace xa {
typedef short bf16x8 __attribute__((ext_vector_type(8)));
typedef float f32x16 __attribute__((ext_vector_type(16)));
typedef float f32x2_t __attribute__((ext_vector_type(2))); typedef __bf16 bf16x2_t __attribute__((ext_vector_type(2)));
typedef unsigned u32x4 __attribute__((ext_vector_type(4)));
__device__ __forceinline__ int crow(int r, int h) { return (r & 3) + 8 * (r >> 2) + 4 * h; }
__device__ __forceinline__ unsigned cvtpk(float lo, float hi) { f32x2_t v = {lo, hi}; bf16x2_t b = __builtin_convertvector(v, bf16x2_t); return __builtin_bit_cast(unsigned, b); }
__device__ __forceinline__ int pos2key16(int p) { return 8 * ((p & 7) >> 2) + 4 * (p >> 3) + (p & 3); }
constexpr int XSCR_OFF = RING_BYTES + 1024;
constexpr float C2 = 0.08838834764831845f * 1.4426950408889634f;

__device__ __forceinline__ void xattn_unit(LAS unsigned char* lds, const bf16* qsrc, int qld, const bf16* gsrc, int gld, bf16* yd, int yld, int row0, const unsigned char* kimg, const unsigned char* vtimg, int tid) {
    const int lane = tid & 63, wid = __builtin_amdgcn_readfirstlane(tid >> 6), r32 = lane & 31, hh = lane >> 5;
    { const unsigned char* src = (wid < 4 ? kimg : vtimg - 65536) + (size_t)wid * 16384 + lane * 16;
#pragma unroll
      for (int i = 0; i < 16; ++i) __builtin_amdgcn_global_load_lds((const GAS unsigned*)(src + i * 1024), (LAS unsigned*)(lds + wid * 16384 + i * 1024), 16, 0, 0); }
    bf16x8 qf[8];
    { const bf16* qp = qsrc + (size_t)(row0 + wid * 32 + r32) * qld + hh * 8;
#pragma unroll
      for (int ks = 0; ks < 8; ++ks) qf[ks] = *(const GAS bf16x8*)(qp + ks * 16); }
    asm volatile("s_waitcnt vmcnt(0)" ::: "memory");
    __syncthreads();
    f32x16 s[8];
#pragma unroll
    for (int kb = 0; kb < 8; ++kb) {
        const int key = kb * 32 + r32;
        f32x16 acc;
#pragma unroll
        for (int i = 0; i < 16; ++i) acc[i] = 0.f;
#pragma unroll
        for (int ks = 0; ks < 8; ++ks) {
            const bf16x8 a = *(const LAS bf16x8*)(lds + key * 256 + (((2 * ks + hh) ^ (key & 15)) << 4));
            acc = __builtin_amdgcn_mfma_f32_32x32x16_bf16(a, qf[ks], acc, 0, 0, 0);
        }
        s[kb] = acc;
    }
    float m = s[0][0];
#pragma unroll
    for (int kb = 0; kb < 8; ++kb)
#pragma unroll
        for (int r = 0; r < 16; ++r) m = fmaxf(m, s[kb][r]);
    m = fmaxf(m, __shfl_xor(m, 32));
    const float mc = m * C2;
    float lsum = 0.f;
#pragma unroll
    for (int kb = 0; kb < 8; ++kb)
#pragma unroll
        for (int r = 0; r < 16; ++r) { const float p = __builtin_amdgcn_exp2f(s[kb][r] * C2 - mc); s[kb][r] = p; lsum += p; }
    lsum += __shfl_xor(lsum, 32);
    __syncthreads();
    f32x16 o[4];
#pragma unroll
    for (int db = 0; db < 4; ++db)
#pragma unroll
        for (int i = 0; i < 16; ++i) o[db][i] = 0.f;
#pragma unroll
    for (int kb = 0; kb < 8; ++kb)
#pragma unroll
        for (int st = 0; st < 2; ++st) {
            u32x4 pw;
#pragma unroll
            for (int j = 0; j < 4; ++j) pw[j] = cvtpk(s[kb][8 * st + 2 * j], s[kb][8 * st + 2 * j + 1]);
            const bf16x8 pa = __builtin_bit_cast(bf16x8, pw);
            const int c = 4 * kb + 2 * st + hh;
#pragma unroll
            for (int db = 0; db < 4; ++db) {
                const int d = db * 32 + r32;
                const bf16x8 b = *(const LAS bf16x8*)(lds + 65536 + d * 512 + ((((c & 15) ^ (d & 15)) | (c & 16)) << 4));
                o[db] = __builtin_amdgcn_mfma_f32_32x32x16_bf16(pa, b, o[db], 0, 0, 0);
            }
        }
    LAS float* lsc = (LAS float*)(lds + XSCR_OFF + wid * 128);
    if (hh == 0) lsc[r32] = lsum;
    asm volatile("s_waitcnt lgkmcnt(0)" ::: "memory");
    LAS bf16* stg = (LAS bf16*)(lds + wid * 8192);
#pragma unroll
    for (int r = 0; r < 16; ++r) {
        const int q = crow(r, hh); const float rl = 1.0f / lsc[q];
#pragma unroll
        for (int db = 0; db < 4; ++db) stg[q * 128 + db * 32 + r32] = (bf16)f2bf(o[db][r] * rl);
    }
    asm volatile("s_waitcnt lgkmcnt(0)" ::: "memory");
#pragma unroll
    for (int i = 0; i < 8; ++i) {
        const int idx = i * 64 + lane, row = idx >> 4, ch = idx & 15;
        const u32x4 ov = *(const LAS u32x4*)(stg + row * 128 + ch * 8);
        const size_t grow = (size_t)(row0 + wid * 32 + row);
        const u32x4 gv = *(const GAS u32x4*)(gsrc + grow * gld + ch * 8);
        u32x4 w;
#pragma unroll
        for (int j = 0; j < 4; ++j) w[j] = pk2(bflo(ov[j]) * silu(bflo(gv[j])), bfhi(ov[j]) * silu(bfhi(gv[j])));
        *(GAS u32x4*)(yd + grow * yld + ch * 8) = w;
    }
    __syncthreads();
}
}

__device__ __forceinline__ void phase_img(const bf16* MKV, unsigned char* KIMG, unsigned char* VTIMG, int gt, int NGT) {
    for (int it = gt; it < 40 * 4096; it += NGT) {
        const int img = it >> 12, key = (it >> 4) & 255, c = it & 15, ls = img >> 2, h = img & 3;
        const v4u v = *(const GAS v4u*)(MKV + ((size_t)ls * 256 + key) * DM + h * 128 + c * 8);
        *(GAS v4u*)(KIMG + (size_t)img * 65536 + key * 256 + ((c ^ (key & 15)) << 4)) = v;
    }
    for (int it = gt; it < 40 * 4096; it += NGT) {
        const int img = it >> 12, d = (it >> 5) & 127, c = it & 31, ls = img >> 2, h = img & 3;
        const bf16* vsrc = MKV + (size_t)ls * 256 * DM + 512 + h * 128 + d;
        unsigned short e[8];
#pragma unroll
        for (int j = 0; j < 8; ++j) { const int p = c * 8 + j, key = (p & ~15) + xa::pos2key16(p & 15); e[j] = vsrc[(size_t)key * DM]; }
        v4u v; v.x = e[0] | ((unsigned)e[1] << 16); v.y = e[2] | ((unsigned)e[3] << 16); v.z = e[4] | ((unsigned)e[5] << 16); v.w = e[6] | ((unsigned)e[7] << 16);
        *(GAS v4u*)(VTIMG + (size_t)img * 65536 + d * 512 + ((((c & 15) ^ (d & 15)) | (c & 16)) << 4)) = v;
    }
}
namespace na {
typedef short bf16x8 __attribute__((ext_vector_type(8)));
typedef short s16x4 __attribute__((ext_vector_type(4)));
typedef float f32x4 __attribute__((ext_vector_type(4)));
typedef unsigned u32x4 __attribute__((ext_vector_type(4)));
constexpr int V_OFF = 61440, RPB_OFF = RING_BYTES + 2048, STG_OFF = RING_BYTES + 4096;
constexpr float LOG2E = 1.4426950408889634f, QS = 0.125f * LOG2E;
__device__ __forceinline__ int clampi(int v, int lo, int hi) { return v < lo ? lo : (v > hi ? hi : v); }
__device__ __forceinline__ s16x4 vtr(unsigned addr) { return __builtin_bit_cast(s16x4, __builtin_amdgcn_ds_read_tr16_b64_v4i16((LAS s16x4*)addr)); }
struct UnitDesc { int seqstart, rows, band, cb, h; };
#define NA_BAR() do { asm volatile("s_waitcnt lgkmcnt(0)" ::: "memory"); __builtin_amdgcn_s_barrier(); asm volatile("" ::: "memory"); } while (0)

__device__ __forceinline__ void stage_image(LAS unsigned char* lds, const bf16* z, const UnitDesc& d, int which, int wid, int lane) {
    const int lo = clampi(d.band * 8 - 4, 0, d.rows - 15), kstart = clampi(16 * d.cb - 8, 0, 32);
    const int key8 = lane >> 3, cp = lane & 7;
    const bf16* zb = z + (size_t)(d.seqstart + lo * 64 + kstart) * INW + (which ? ZV : ZK) + d.h * 64;
#pragma unroll
    for (int j = 0; j < 8; ++j) {
        const int pp = wid + 8 * j;
        if (pp < 60) {
            const int a15 = pp >> 2, key = (pp & 3) * 8 + key8, sw = key >> 1;
            const int c = which ? ((((cp >> 1) ^ (sw & 3)) << 1) | (cp & 1)) : (cp ^ (sw & 7));
            __builtin_amdgcn_global_load_lds((const GAS unsigned*)(zb + (size_t)(a15 * 64 + key) * INW + c * 8), (LAS unsigned*)(lds + which * V_OFF + pp * 1024), 16, 0, 0);
        }
    }
}

template <class Sched> __device__ __forceinline__ void na_phase(LAS unsigned char* lds, const bf16* z, bf16* y, const float* rpb, const Sched& S, int tid) {
    const int lane = tid & 63, wid = __builtin_amdgcn_readfirstlane(tid >> 6), l16 = lane & 15, g = lane >> 4;
    UnitDesc cur, nxt;
    if (!S.next(0, cur)) return;
    stage_image(lds, z, cur, 0, wid, lane); stage_image(lds, z, cur, 1, wid, lane);
    for (int ui = 0;; ++ui) {
        const bool has_next = S.next(ui + 1, nxt);
        const int r = cur.band * 8 + wid, h = cur.h, cb = cur.cb, rows = cur.rows;
        const int lo = clampi(cur.band * 8 - 4, 0, rows - 15), r0 = clampi(r - 4, 0, rows - 8), kstart = clampi(16 * cb - 8, 0, 32);
        if (tid < 465) ((LAS float*)(lds + RPB_OFF))[tid] = rpb[h * 465 + tid] * LOG2E;
        const size_t qtok = (size_t)(cur.seqstart + r * 64 + cb * 16 + l16);
        const bf16x8 qf0 = *(const GAS bf16x8*)(z + qtok * INW + ZQ + h * 64 + g * 8), qf1 = *(const GAS bf16x8*)(z + qtok * INW + ZQ + h * 64 + 32 + g * 8);
        u32x4 gv[2];
#pragma unroll
        for (int i2 = 0; i2 < 2; ++i2) { const int idx = i2 * 64 + lane, q = idx >> 3, ch = idx & 7;
            gv[i2] = *(const GAS u32x4*)(z + (size_t)(cur.seqstart + r * 64 + cb * 16 + q) * INW + ZG + h * 64 + ch * 8); }
        const int qcol = cb * 16 + l16, cs = clampi(qcol - 8, 0, 48), dyb = r0 - r + 7;
        int dxo[8]; bool vld[8];
#pragma unroll
        for (int e = 0; e < 8; ++e) { const int kcol = kstart + 16 * (e >> 2) + 4 * g + (e & 3); vld[e] = (kcol >= cs) && (kcol < cs + 16); dxo[e] = clampi(kcol - qcol + 15, 0, 30); }
        asm volatile("s_waitcnt vmcnt(0)" ::: "memory");
        NA_BAR();
        const int slot0 = r0 - lo;
        f32x4 s[8][2];
#pragma unroll
        for (int a = 0; a < 8; ++a)
#pragma unroll
            for (int cbk = 0; cbk < 2; ++cbk) {
                const int key = 16 * cbk + l16, sw = (key >> 1) & 7;
                LAS unsigned char* kb = lds + (slot0 + a) * 4096 + key * 128;
                const bf16x8 a0 = *(const LAS bf16x8*)(kb + ((g ^ sw) << 4)), a1 = *(const LAS bf16x8*)(kb + (((4 + g) ^ sw) << 4));
                f32x4 acc = (f32x4){0.f, 0.f, 0.f, 0.f};
                acc = __builtin_amdgcn_mfma_f32_16x16x32_bf16(a0, qf0, acc, 0, 0, 0);
                acc = __builtin_amdgcn_mfma_f32_16x16x32_bf16(a1, qf1, acc, 0, 0, 0);
                s[a][cbk] = acc;
            }
        NA_BAR();
        if (has_next) stage_image(lds, z, nxt, 0, wid, lane);
        const LAS float* rp = (const LAS float*)(lds + RPB_OFF);
        float m = -INFINITY;
#pragma unroll
        for (int a = 0; a < 8; ++a)
#pragma unroll
            for (int e = 0; e < 8; ++e) {
                float t = s[a][e >> 2][e & 3] * QS + rp[(a + dyb) * 31 + dxo[e]];
                t = vld[e] ? t : -INFINITY;
                s[a][e >> 2][e & 3] = t; m = fmaxf(m, t);
            }
        m = fmaxf(m, __shfl_xor(m, 16)); m = fmaxf(m, __shfl_xor(m, 32));
        float lsum = 0.f;
#pragma unroll
        for (int a = 0; a < 8; ++a)
#pragma unroll
            for (int e = 0; e < 8; ++e) { const float p = __builtin_amdgcn_exp2f(s[a][e >> 2][e & 3] - m); s[a][e >> 2][e & 3] = p; lsum += p; }
        lsum += __shfl_xor(lsum, 16); lsum += __shfl_xor(lsum, 32);
        f32x4 o[4];
#pragma unroll
        for (int db = 0; db < 4; ++db) o[db] = (f32x4){0.f, 0.f, 0.f, 0.f};
        const int qq = l16 >> 2, pq = l16 & 3, klo = 4 * g + qq;
        const unsigned vlane = (unsigned)(uintptr_t)(lds + V_OFF) + klo * 128 + 8 * pq;
        const int vsw = (klo >> 1) & 3;
#pragma unroll
        for (int a = 0; a < 8; ++a) {
            u32x4 pw; pw[0] = xa::cvtpk(s[a][0][0], s[a][0][1]); pw[1] = xa::cvtpk(s[a][0][2], s[a][0][3]); pw[2] = xa::cvtpk(s[a][1][0], s[a][1][1]); pw[3] = xa::cvtpk(s[a][1][2], s[a][1][3]);
            const bf16x8 pa = __builtin_bit_cast(bf16x8, pw);
            const unsigned vb = vlane + (slot0 + a) * 4096;
#pragma unroll
            for (int db = 0; db < 4; ++db) {
                const s16x4 vl = vtr(vb + ((db ^ vsw) << 5)), vh = vtr(vb + 2048 + ((db ^ vsw) << 5));
                const bf16x8 b = (bf16x8){vl[0], vl[1], vl[2], vl[3], vh[0], vh[1], vh[2], vh[3]};
                o[db] = __builtin_amdgcn_mfma_f32_16x16x32_bf16(pa, b, o[db], 0, 0, 0);
            }
        }
        NA_BAR();
        if (has_next) stage_image(lds, z, nxt, 1, wid, lane);
        float rl[4];
#pragma unroll
        for (int i = 0; i < 4; ++i) rl[i] = 1.0f / __shfl(lsum, 4 * g + i);
        LAS bf16* stg = (LAS bf16*)(lds + STG_OFF + wid * 2048);
#pragma unroll
        for (int db = 0; db < 4; ++db)
#pragma unroll
            for (int i = 0; i < 4; ++i) stg[(4 * g + i) * 64 + 16 * db + l16] = (bf16)f2bf(o[db][i] * rl[i]);
        asm volatile("s_waitcnt lgkmcnt(0)" ::: "memory");
#pragma unroll
        for (int i2 = 0; i2 < 2; ++i2) {
            const int idx = i2 * 64 + lane, q = idx >> 3, ch = idx & 7;
            const u32x4 ov = *(const LAS u32x4*)(stg + q * 64 + ch * 8);
            const size_t tok = (size_t)(cur.seqstart + r * 64 + cb * 16 + q);
            u32x4 w;
#pragma unroll
            for (int j = 0; j < 4; ++j) w[j] = pk2(bflo(ov[j]) * silu(bflo(gv[i2][j])), bfhi(ov[j]) * silu(bfhi(gv[i2][j])));
            *(GAS u32x4*)(y + tok * BRW + h * 64 + ch * 8) = w;
        }
        if (!has_next) break;
        cur = nxt;
    }
    __syncthreads();
}
#undef NA_BAR
struct XcdOrder {
    int G, vcu, seqlen;
    __device__ __forceinline__ bool next(int i, UnitDesc& d) const {
        const int rows = seqlen / 64, bps = rows / 8;
        int b32, h, cb;
        if (G % 8 == 0 && G >= 8) { const int per = G / 8, x = vcu / per, j = vcu % per, e = i * per + j; if (e >= 384) return false; b32 = e / 12; const int rem = e % 12; h = 3 * x + (rem >> 2); cb = rem & 3; }
        else { const int u = i * G + vcu; if (u >= 3072) return false; cb = u & 3; h = (u >> 2) % NAH; b32 = (u >> 2) / NAH; }
        d.seqstart = (b32 / bps) * seqlen; d.rows = rows; d.band = b32 % bps; d.cb = cb; d.h = h; return true;
    }
};
}
struct Args { const float* in[13]; float* out; unsigned char* ws; int ph_lo, ph_hi; };
__global__ void __launch_bounds__(NWAVES * 64, 2) fwd_kernel(Args args) {
    extern __shared__ __attribute__((aligned(16))) unsigned char lds_raw[];
    LAS unsigned char* lds = (LAS unsigned char*)lds_raw;
    volatile LAS unsigned* MISC = (volatile LAS unsigned*)(lds + MISC_OFF);
#define KARG(off) karg64<(off)>()
#define LOAD_PTRS() Ptrs P; do { unsigned char* ws_ = (unsigned char*)(GAS unsigned char*)KARG(112); \
    P.xp = (const float*)(const GAS float*)KARG(0); P.xs = (const float*)(const GAS float*)KARG(8); P.memp = (const float*)(const GAS float*)KARG(16); P.mems = (const float*)(const GAS float*)KARG(24); P.norm_w = (const float*)(const GAS float*)KARG(32); \
    P.w_in = (const float*)(const GAS float*)KARG(40); P.w_out = (const float*)(const GAS float*)KARG(48); P.mem_norm_w = (const float*)(const GAS float*)KARG(56); P.w_mem_kv = (const float*)(const GAS float*)KARG(64); P.conv_w = (const float*)(const GAS float*)KARG(72); \
    P.conv_b = (const float*)(const GAS float*)KARG(80); P.na_rpb = (const float*)(const GAS float*)KARG(88); P.final_norm_w = (const float*)(const GAS float*)KARG(96); P.out = (float*)(GAS float*)KARG(104); \
    P.W1T = (bf16*)(ws_ + WS_W1T); P.W2T = (bf16*)(ws_ + WS_W2T); P.WKVT = (bf16*)(ws_ + WS_WKVT); P.MEMN = (bf16*)(ws_ + WS_MEMN); P.MKV = (bf16*)(ws_ + WS_MKV); \
    P.HB = (bf16*)(ws_ + WS_HB); P.Y = (bf16*)(ws_ + WS_Y); P.Z = (bf16*)(ws_ + WS_Z); P.KIMG = ws_ + WS_KIMG; P.VTIMG = ws_ + WS_VTIMG; P.YF = (bf16*)(ws_ + WS_YF); P.ZX = (bf16*)(ws_ + WS_ZX); P.EDGE = (float*)(ws_ + WS_EDGE); } while (0)
    for (int u = threadIdx.x; u < (LDS_BYTES - LDSCTL_OFF) / 4; u += NWAVES * 64) ((LAS unsigned*)(lds + LDSCTL_OFF))[u] = 0u;
    __syncthreads();
    const int lo = args.ph_lo, hi = args.ph_hi;
    if (hi - lo > 1) (void)xcd_barrier_post((unsigned*)((gu32*)((GAS unsigned char*)KARG(112) + WS_CTL) + CW_BAR), MISC + 8);

    for (int ph = lo; ph < hi; ++ph) {
        int tid = threadIdx.x; asm volatile("" : "+v"(tid));
        int bx = blockIdx.x; asm volatile("" : "+s"(bx));
        int G = gridDim.x; asm volatile("" : "+s"(G));
        const int lane = tid & 63, wave = __builtin_amdgcn_readfirstlane(tid >> 6);
        const int vcu = (G % 8 == 0) ? (bx % 8) * (G / 8) + bx / 8 : bx;
        const int gw = vcu * NWAVES + wave, NGW = G * NWAVES;
        const int gt = vcu * (NWAVES * 64) + tid, NGT = G * NWAVES * 64;
        LOAD_PTRS();
        if (ph == PH_PREP) {
            phase_prep(P, lds, gw, NGW, wave, lane);
        } else if (ph == PH_MKV) {
            for (int l = 0; l < 2; ++l) {
                pg8::Gemm g{P.MEMN + (size_t)l * MEMROWS * DM, P.WKVT + (size_t)l * DM * DM, MEMROWS, DM, DM};
                pg8::StaticOrder S; S.init(MEMROWS, DM, G, (bx + 128 * l) % G);
                pg8::EpiBf16<0> E{P.MKV + (size_t)l * MEMROWS * DM, DM, nullptr, 0, 0, 1.f};
                pg8::gemm_phase<pg8::EpiBf16<0>, pg8::StaticOrder, true, true>(lds + RING_OFF, g, S, E, tid);
            }
        } else if (ph == PH_IMG) {
            phase_img(P.MKV, P.KIMG, P.VTIMG, gt, NGT);
        } else if (ph == PH_G1_0) {
            pg8::Gemm g{P.HB, P.W1T, TOK, INW, DM};
            pg8::StaticOrder S; S.init(TOK, INW, G, bx);
            pg8::EpiConv E{P.YF, P.ZX, P.EDGE, P.conv_w, P.conv_b, lds + XL_OFF};
            pg8::gemm_phase<pg8::EpiConv, pg8::StaticOrder, true, true>(lds + RING_OFF, g, S, E, tid);
        } else if (ph == PH_MIX_0) {
            phase_edgefix(P, gt, NGT);
            for (int u = vcu; u < (TOK / 256) * XH; u += G) {
                const int pm = u >> 2, h = u & 3, grow = pm * 256, seq = (grow < 32768) ? (grow >> 13) : 4, img = seq * 4 + h;
                xa::xattn_unit(lds, P.ZX + h * 128, 1024, P.ZX + 512 + h * 128, 1024, P.YF + MIXW + h * 128, BRW, grow, P.KIMG + (size_t)img * 65536, P.VTIMG + (size_t)img * 65536, tid);
            }
        } else if (ph == PH_G2_0) {
            pg8::Gemm g{P.YF, P.W2T, TOK, DM, BRW};
            pg8::StaticOrder S; S.init(TOK, DM, G, bx);
            pg8::EpiRes2 E{P.xp, P.xs, P.out, 128};
            pg8::gemm_phase<pg8::EpiRes2, pg8::StaticOrder, true, true>(lds + RING_OFF, g, S, E, tid);
        } else if (ph == PH_NORM_0) {
            for (int m = gw; m < TOK; m += NGW) rms_row_to_bf16(P.out + (size_t)m * DM, P.norm_w + DM, P.HB + (size_t)m * DM, lane);
        } else if (ph == PH_NORM_1) {
            for (int m = gw; m < TOK; m += NGW) rms_row_to_f32(P.out + (size_t)m * DM, P.final_norm_w, P.out + (size_t)m * DM, lane);
        } else {
            const int r = ph - PH_L1, chunk = r / 3, kind = r % 3;
            if (kind == 0) {
                pg8::Gemm g{P.HB + (size_t)chunk * CH * DM, P.W1T + (size_t)INW * DM, CH, INW, DM};
                pg8::StaticOrder S; S.init(CH, INW, G, bx);
                pg8::EpiBf16<0> E{P.Z, INW, nullptr, 0, 0, 1.f};
                pg8::gemm_phase<pg8::EpiBf16<0>, pg8::StaticOrder, true, true>(lds + RING_OFF, g, S, E, tid);
            } else if (kind == 1) {
                { na::XcdOrder S{G, vcu, (chunk == 2) ? 16384 : 8192}; na::na_phase(lds, P.Z, P.Y, P.na_rpb, S, tid); }
                for (int u = vcu; u < (CH / 256) * XH; u += G) {
                    const int pm = u >> 2, h = u & 3, grow = chunk * CH + pm * 256, seq = (grow < 32768) ? (grow >> 13) : 4, img = (5 + seq) * 4 + h;
                    xa::xattn_unit(lds, P.Z + ZQM + h * 128, INW, P.Z + ZG + MIXW + h * 128, INW, P.Y + MIXW + h * 128, BRW, pm * 256, P.KIMG + (size_t)img * 65536, P.VTIMG + (size_t)img * 65536, tid);
                }
            } else {
                pg8::Gemm g{P.Y, P.W2T + (size_t)DM * BRW, CH, DM, BRW};
                pg8::StaticOrder S; S.init(CH, DM, G, bx);
                pg8::EpiRes2 E{P.out + (size_t)chunk * CH * DM, P.out + (size_t)chunk * CH * DM, P.out + (size_t)chunk * CH * DM, 1 << 20};
                pg8::gemm_phase<pg8::EpiRes2, pg8::StaticOrder, true, true>(lds + RING_OFF, g, S, E, tid);
            }
        }
        if (ph + 1 < hi) { XcdBarrier bar; bar.bar = (unsigned*)((gu32*)((GAS unsigned char*)KARG(112) + WS_CTL) + CW_BAR); bar.x = xb_xcc_id(); bar.st = MISC + 8; xcd_barrier(bar); }
    }
}

extern "C" void kernel_launch(void* const* d_in, const int* in_sizes, int n_in, void* d_out, int out_size, void* d_ws, size_t ws_size, hipStream_t stream) {
    static int grid = 0;
    if (grid == 0) {
        if (n_in != 13 || out_size != TOK * DM || ws_size < WS_END) { fprintf(stderr, "kernel_launch: unexpected shapes (n_in %d out %d ws %zu)\n", n_in, out_size, ws_size); grid = -1; return; }
        int dev = 0, cus = 0, per_cu = 0;
        if (hipGetDevice(&dev) != hipSuccess || hipDeviceGetAttribute(&cus, hipDeviceAttributeMultiprocessorCount, dev) != hipSuccess) { grid = -1; return; }
        if (hipFuncSetAttribute((const void*)fwd_kernel, hipFuncAttributeMaxDynamicSharedMemorySize, LDS_BYTES) != hipSuccess) { fprintf(stderr, "kernel_launch: hipFuncSetAttribute failed\n"); grid = -1; return; }
        if (hipOccupancyMaxActiveBlocksPerMultiprocessor(&per_cu, (const void*)fwd_kernel, NWAVES * 64, LDS_BYTES) != hipSuccess || per_cu < 1) { fprintf(stderr, "kernel_launch: occupancy query says %d\n", per_cu); per_cu = 1; }
        (void)hipGetLastError();
        grid = cus;
    }
    if (grid < 0) return;
    (void)hipMemsetAsync((char*)d_ws + WS_CTL, 0, CTL_ZERO_BYTES, stream);
    Args a{};
    for (int i = 0; i < 13; ++i) a.in[i] = (const float*)d_in[i];
    a.out = (float*)d_out; a.ws = (unsigned char*)d_ws;
#if defined(PROBE_MODE)
    for (int ph = 0; ph < NPHASE; ++ph) {
        int reps = 1; const int r = ph - PH_L1, kind = r % 3;
        if (PROBE_MODE == 2 && ph == PH_G1_0) reps = PROBE_REPS;
        if (PROBE_MODE == 3 && ph == PH_MIX_0) reps = PROBE_REPS;
        if (PROBE_MODE == 4 && ph >= PH_L1 && ph < PH_NORM_1 && kind == 1) reps = PROBE_REPS;
        if (PROBE_MODE == 5 && ph == PH_G2_0) reps = PROBE_REPS;
        if (PROBE_MODE == 6 && (ph == PH_PREP || ph == PH_NORM_0)) reps = PROBE_REPS;
        if (PROBE_MODE == 7 && (ph == PH_MKV || ph == PH_IMG)) reps = PROBE_REPS;
        if (PROBE_MODE == 8 && ph >= PH_L1 && ph < PH_NORM_1 && kind == 0) reps = PROBE_REPS;
        for (int i = 0; i < reps; ++i) { a.ph_lo = ph; a.ph_hi = ph + 1; hipLaunchKernelGGL(fwd_kernel, dim3(grid), dim3(NWAVES * 64), LDS_BYTES, stream, a); }
    }
#elif MK_ONE_LAUNCH
    a.ph_lo = 0; a.ph_hi = NPHASE;
    hipLaunchKernelGGL(fwd_kernel, dim3(grid), dim3(NWAVES * 64), LDS_BYTES, stream, a);
#else
    for (int ph = 0; ph < NPHASE; ++ph) { a.ph_lo = ph; a.ph_hi = ph + 1;
        hipLaunchKernelGGL(fwd_kernel, dim3(grid), dim3(NWAVES * 64), LDS_BYTES, stream, a); }
#endif
}
```

```cpp
#include <hip/hip_runtime.h>
#include <cstdio>
#include <cstdint>
namespace pg8 {
#define PG8_LAS __attribute__((address_space(3)))
typedef unsigned short bf16_t;
typedef short bf16x8 __attribute__((ext_vector_type(8)));
typedef float f32x4 __attribute__((ext_vector_type(4)));
typedef unsigned u32x4 __attribute__((ext_vector_type(4)));
constexpr int BM = 256, BK = 64, HALF = 128, HTB = HALF * BK * 2  , STAGE_BYTES = 8 * HTB, NXCD = 8, WGM = 8;

__host__ __device__ __forceinline__ int lds_byte(int r, int c) { const int st = (r >> 4) * 2 + (c >> 5), rr = r & 15, cc = c & 31, ob = rr * 64 + cc * 2; return st * 1024 + (ob ^ (((ob >> 9) & 1) << 5)); }
__host__ __device__ __forceinline__ void stage_rc(int b, int& R, int& C) { const int st = b / 1024, sb = b % 1024, swz = sb ^ (((sb >> 9) & 1) << 5); R = (st >> 1) * 16 + swz / 64; C = (st & 1) * 32 + (swz % 64) / 2; }
__host__ __device__ __forceinline__ int perm32(int rho) { const int n = rho >> 4, i = rho & 15; return 8 * (i >> 2) + 4 * n + (i & 3); }

struct Unit { int pm, pn; };
struct Gemm { const bf16_t* A; const bf16_t* Bt; int M, N, K; };

struct StaticOrder {
    int nM, nN, nwg, G, c;
    __host__ __device__ void init(int M, int N, int G_, int c_) { nM = M / BM; nN = N / BM; nwg = nM * nN; G = G_; c = c_; }
    __host__ __device__ bool next(int i, Unit& u) const {
        const long L = (long)i * G + c; if (L >= nwg) return false;
        int wgid = (int)L; { const int q = nwg / NXCD, r = nwg % NXCD, xcd = wgid % NXCD, off = wgid / NXCD; wgid = (xcd < r ? xcd * (q + 1) : r * (q + 1) + (xcd - r) * q) + off; }
        const int nig = WGM * nN, gid = wgid / nig, fm = gid * WGM, gsz = (nM - fm) < WGM ? (nM - fm) : WGM;
        u.pm = fm + ((wgid % nig) % gsz); u.pn = (wgid % nig) / gsz; return true;
    }
    __device__ __forceinline__ void a_ready(const Unit&) const {}
    __device__ __forceinline__ void done(const Unit&) const {}
};

__device__ __forceinline__ unsigned cvt_pk_bf16(float lo, float hi) { unsigned r; asm volatile("v_cvt_pk_bf16_f32 %0, %1, %2" : "=v"(r) : "v"(lo), "v"(hi)); return r; }
typedef float f32x2 __attribute__((ext_vector_type(2)));
__device__ __forceinline__ f32x2 gelu_pk(f32x2 v) {
    const f32x2 av = __builtin_elementwise_abs(v), d = av * 0.2316418882f + 1.0f;
    f32x2 t; t.x = __builtin_amdgcn_rcpf(d.x); t.y = __builtin_amdgcn_rcpf(d.y);
    f32x2 q = t * 0.5307027145f + (-0.7265760135f); q = q * t + 0.7107068705f; q = q * t + (-0.142248368f); q = q * t + 0.127414796f; q = q * t;
    const f32x2 s = (v * v) * (-0.72134752044f);
    f32x2 e; e.x = __builtin_amdgcn_exp2f(s.x); e.y = __builtin_amdgcn_exp2f(s.y);
    const f32x2 m = v * (q * e), r = v - m;
    f32x2 o; o.x = v.x < 0.f ? m.x : r.x; o.y = v.y < 0.f ? m.y : r.y; return o;
}

template <int ACT  > struct EpiBf16 {
    static constexpr bool PERM = true, AFTER_DRAIN = false; static_assert(ACT == 0 || ACT == 1, "EpiBf16: ACT is 0 (none) or 1 (gelu_pk)");
    bf16_t* O; int ldc; const float* bias; int split_cols; size_t split_stride; float scale0;
    __device__ __forceinline__ void operator()(const f32x4 (&acc)[2][2][4][2], const Unit& u, int wr, int wc, int fr, int fq) const {
        const int row0 = u.pm * BM + wr * 64 + fr; int colt = u.pn * BM; bf16_t* base = O;
        float sc = 1.f; if (split_cols) { const int t = colt / split_cols; base += (size_t)t * split_stride; colt -= t * split_cols; if (t == 0) sc = scale0; }
        const int col0 = colt + wc * 32 + 8 * fq, bcol0 = u.pn * BM + wc * 32 + 8 * fq;
        f32x4 bv[2][2];
#pragma unroll
        for (int bj = 0; bj < 2; ++bj)
#pragma unroll
            for (int n = 0; n < 2; ++n) bv[bj][n] = bias ? *(const f32x4*)(bias + bcol0 + bj * HALF + 4 * n) : (f32x4){0.f, 0.f, 0.f, 0.f};
#pragma unroll
        for (int ai = 0; ai < 2; ++ai)
#pragma unroll
            for (int m = 0; m < 4; ++m) { bf16_t* rowp = base + (size_t)(row0 + ai * HALF + m * 16) * ldc + col0;
#pragma unroll
                for (int bj = 0; bj < 2; ++bj) { f32x4 v0 = acc[ai][bj][m][0] + bv[bj][0], v1 = acc[ai][bj][m][1] + bv[bj][1];
                    if (ACT == 1) { f32x2 a = gelu_pk((f32x2){v0[0], v0[1]}), b = gelu_pk((f32x2){v0[2], v0[3]}), c = gelu_pk((f32x2){v1[0], v1[1]}), d = gelu_pk((f32x2){v1[2], v1[3]});
                        v0 = (f32x4){a.x, a.y, b.x, b.y}; v1 = (f32x4){c.x, c.y, d.x, d.y}; }
                    v0 = v0 * sc; v1 = v1 * sc; u32x4 w; w.x = cvt_pk_bf16(v0[0], v0[1]); w.y = cvt_pk_bf16(v0[2], v0[3]); w.z = cvt_pk_bf16(v1[0], v1[1]); w.w = cvt_pk_bf16(v1[2], v1[3]);
                    *(u32x4*)(rowp + bj * HALF) = w; } }
    }
};
struct EpiResF32 {
    static constexpr bool PERM = false, AFTER_DRAIN = false;
    const float* base; float* out; int ldc;
    __device__ __forceinline__ void operator()(const f32x4 (&acc)[2][2][4][2], const Unit& u, int wr, int wc, int fr, int fq) const {
        const int row0 = u.pm * BM + wr * 64 + fr, col0 = u.pn * BM + wc * 32 + 4 * fq;
#pragma unroll
        for (int ai = 0; ai < 2; ++ai)
#pragma unroll
            for (int m = 0; m < 4; ++m) { const size_t off = (size_t)(row0 + ai * HALF + m * 16) * ldc + col0;
#pragma unroll
                for (int bj = 0; bj < 2; ++bj)
#pragma unroll
                    for (int n = 0; n < 2; ++n) { const f32x4 bs = *(const f32x4*)(base + off + bj * HALF + n * 16); *(f32x4*)(out + off + bj * HALF + n * 16) = bs + acc[ai][bj][m][n]; }
                if (m & 1) asm volatile("" ::: "memory"); }
    }
};
__host__ __device__ __forceinline__ int origcol0(int np) {
    const int tile = np >> 8, c = np & 255;
    if (tile < 24) { const int bj = c >> 7, wc = (c >> 5) & 3, n = (c >> 4) & 1, q = 2 * bj + n; const int qoff = (q == 0) ? 0 : (q == 1) ? 1536 : (q == 2) ? 3072 : 5120; return qoff + 64 * tile + 16 * wc + (c & 15); }
    const int zc = 256 * (tile - 24) + (c & ~31) + perm32(c & 31);
    return zc < 512 ? 4608 + zc : 6656 + (zc - 512);
}
template <int CTRL> __device__ __forceinline__ float dpp_f(float v) { return __builtin_bit_cast(float, __builtin_amdgcn_update_dpp(0, __builtin_bit_cast(int, v), CTRL, 0xf, 0xf, false)); }
__device__ __forceinline__ f32x4 ror1(f32x4 v) { return (f32x4){dpp_f<0x121>(v[0]), dpp_f<0x121>(v[1]), dpp_f<0x121>(v[2]), dpp_f<0x121>(v[3])}; }
__device__ __forceinline__ f32x4 ror15(f32x4 v) { return (f32x4){dpp_f<0x12f>(v[0]), dpp_f<0x12f>(v[1]), dpp_f<0x12f>(v[2]), dpp_f<0x12f>(v[3])}; }
__device__ __forceinline__ float silu_f(float g) { return g * __builtin_amdgcn_rcpf(1.0f + __builtin_amdgcn_exp2f(-1.4426950408889634f * g)); }
constexpr int EDGE_TILE_FLOATS = 2 * 3 * 1536;
struct EpiConv {
    static constexpr bool PERM = false, AFTER_DRAIN = false;
    bf16_t* Y; bf16_t* ZX; float* EDGE; const float* cw; const float* cb; PG8_LAS unsigned char* xl;
    __device__ __forceinline__ void operator()(const f32x4 (&acc)[2][2][4][2], const Unit& u, int wr, int wc, int fr, int fq) const {
        if (u.pn >= 24) {
            const int row0 = u.pm * BM + wr * 64 + fr, col0 = (u.pn - 24) * BM + wc * 32 + 8 * fq;
#pragma unroll
            for (int ai = 0; ai < 2; ++ai)
#pragma unroll
                for (int m = 0; m < 4; ++m) { bf16_t* rowp = ZX + (size_t)(row0 + ai * HALF + m * 16) * 1024 + col0;
#pragma unroll
                    for (int bj = 0; bj < 2; ++bj) { const f32x4 v0 = acc[ai][bj][m][0], v1 = acc[ai][bj][m][1];
                        u32x4 w; w.x = cvt_pk_bf16(v0[0], v0[1]); w.y = cvt_pk_bf16(v0[2], v0[3]); w.z = cvt_pk_bf16(v1[0], v1[1]); w.w = cvt_pk_bf16(v1[2], v1[3]);
                        *(u32x4*)(rowp + bj * HALF) = w; } }
            return;
        }
        const int lane = fq * 16 + fr, wid = wr * 4 + wc, chl = 16 * wc + 4 * fq, ch0 = 64 * u.pn + chl;
        const f32x4 w0 = *(const f32x4*)(cw + ch0), w1 = *(const f32x4*)(cw + 1536 + ch0), w2 = *(const f32x4*)(cw + 3072 + ch0), bb = *(const f32x4*)(cb + ch0);
        PG8_LAS float* xb = (PG8_LAS float*)(xl + 16384);
        f32x4 v[2][4];
#pragma unroll
        for (int ai = 0; ai < 2; ++ai) {
#pragma unroll
            for (int m = 0; m < 4; ++m) v[ai][m] = acc[ai][0][m][1] * acc[ai][1][m][0];
            const int blk = 2 * ai + wr;
            if (fr == 0) *(PG8_LAS f32x4*)(xb + (blk * 2 + 0) * 64 + chl) = v[ai][0];
            if (fr == 15) *(PG8_LAS f32x4*)(xb + (blk * 2 + 1) * 64 + chl) = v[ai][3];
        }
        asm volatile("s_waitcnt lgkmcnt(0)" ::: "memory"); __builtin_amdgcn_s_barrier(); asm volatile("" ::: "memory");
        const f32x4 zero4 = (f32x4){0.f, 0.f, 0.f, 0.f};
#pragma unroll
        for (int ai = 0; ai < 2; ++ai) {
            const int blk = 2 * ai + wr;
            f32x4 vprev = zero4, vnext = zero4;
            if (blk > 0) vprev = *(const PG8_LAS f32x4*)(xb + ((blk - 1) * 2 + 1) * 64 + chl);
            if (blk < 3) vnext = *(const PG8_LAS f32x4*)(xb + ((blk + 1) * 2 + 0) * 64 + chl);
#pragma unroll
            for (int m = 0; m < 4; ++m) {
                const f32x4 vc = v[ai][m];
                const f32x4 upa = ror1(vc), upb = (m > 0) ? ror1(v[ai][m > 0 ? m - 1 : 0]) : vprev;
                const f32x4 dna = ror15(vc), dnb = (m < 3) ? ror15(v[ai][m < 3 ? m + 1 : 3]) : vnext;
                const f32x4 up = (fr > 0) ? upa : upb, dn = (fr < 15) ? dna : dnb;
                const f32x4 conv = w0 * up + w1 * vc + w2 * dn + bb;
                const f32x4 p0 = acc[ai][0][m][0], gt = acc[ai][1][m][1];
                f32x4 pg, yv;
#pragma unroll
                for (int e = 0; e < 4; ++e) { pg[e] = p0[e] * silu_f(gt[e]); yv[e] = pg[e] * conv[e]; }
                if ((blk == 0 && m == 0 && fr == 0) || (blk == 3 && m == 3 && fr == 15)) {
                    float* eb = EDGE + (size_t)u.pm * EDGE_TILE_FLOATS + (blk == 0 ? 0 : 3 * 1536) + ch0;
                    *(f32x4*)(eb) = pg; *(f32x4*)(eb + 1536) = vc; *(f32x4*)(eb + 3072) = yv;
                }
                const int row = wr * 64 + m * 16 + fr;
                typedef unsigned u32x2 __attribute__((ext_vector_type(2)));
                u32x2 pk; pk.x = cvt_pk_bf16(yv[0], yv[1]); pk.y = cvt_pk_bf16(yv[2], yv[3]);
                *(PG8_LAS u32x2*)(xl + row * 128 + (((chl >> 2) ^ (row & 15)) << 3)) = pk;
            }
            asm volatile("s_waitcnt lgkmcnt(0)" ::: "memory"); __builtin_amdgcn_s_barrier(); asm volatile("" ::: "memory");
#pragma unroll
            for (int i = 0; i < 2; ++i) {
                const int idx = i * 512 + wid * 64 + lane, row = idx >> 3, c8 = idx & 7;
                u32x4 ov = *(const PG8_LAS u32x4*)(xl + row * 128 + (((2 * c8) ^ (row & 14)) << 3));
                if (row & 1) ov = (u32x4){ov.z, ov.w, ov.x, ov.y};
                *(u32x4*)(Y + (size_t)(u.pm * BM + ai * HALF + row) * 2048 + 64 * u.pn + c8 * 8) = ov;
            }
            if (ai == 0) { asm volatile("s_waitcnt lgkmcnt(0)" ::: "memory"); __builtin_amdgcn_s_barrier(); asm volatile("" ::: "memory"); }
        }
    }
};
__device__ __forceinline__ f32x4 ror8(f32x4 v) { return (f32x4){dpp_f<0x128>(v[0]), dpp_f<0x128>(v[1]), dpp_f<0x128>(v[2]), dpp_f<0x128>(v[3])}; }
struct EpiRes2 {
    static constexpr bool PERM = false, AFTER_DRAIN = false;
    const float* b0; const float* b1; float* out; int split_pm;
    __device__ __forceinline__ void operator()(const f32x4 (&acc)[2][2][4][2], const Unit& u, int wr, int wc, int fr, int fq) const {
        const bool hi = fr >= 8; const int r8 = fr & 7;
        const int row0 = u.pm * BM + wr * 64 + r8, col0 = u.pn * BM + wc * 32 + 4 * fq + (hi ? 16 : 0);
        const float* bsel = (u.pm < split_pm) ? b0 + (size_t)row0 * 1024 : b1 + (size_t)(row0 - split_pm * BM) * 1024;
        float* osel = out + (size_t)row0 * 1024;
#pragma unroll
        for (int ai = 0; ai < 2; ++ai)
#pragma unroll
            for (int m = 0; m < 4; ++m) { const size_t off = (size_t)(ai * HALF + m * 16) * 1024 + col0;
#pragma unroll
                for (int bj = 0; bj < 2; ++bj) {
                    const f32x4 a0 = acc[ai][bj][m][0], a1 = acc[ai][bj][m][1], x = ror8(a1), y = ror8(a0);
                    const f32x4 d1 = hi ? x : a0, d2 = hi ? a1 : y;
                    const f32x4 r1 = *(const f32x4*)(bsel + off + bj * HALF), r2 = *(const f32x4*)(bsel + off + bj * HALF + 8 * 1024);
                    *(f32x4*)(osel + off + bj * HALF) = r1 + d1; *(f32x4*)(osel + off + bj * HALF + 8 * 1024) = r2 + d2; }
                if (m & 1) asm volatile("" ::: "memory"); }
    }
};
template <class Epi, class Sched, bool ALIGN_EPI = false, bool SP2 = false>
__device__ __forceinline__ void gemm_phase(PG8_LAS unsigned char* lds, const Gemm g, const Sched& S, const Epi& E, const int tid) {
    const int wid = __builtin_amdgcn_readfirstlane(tid >> 6), lane = tid & 63, wr = wid >> 2, wc = wid & 3, fr = lane & 15, fq = lane >> 4;
    const int K = g.K, nt = K / BK;
    unsigned voffA[2], voffB[2];
#pragma unroll
    for (int i = 0; i < 2; ++i) { int R, C; stage_rc(tid * 16 + i * 8192, R, C); const int Rb = Epi::PERM ? ((R & ~31) + perm32(R & 31)) : R;
        voffA[i] = (unsigned)(R * K + C) * 2u; voffB[i] = (unsigned)(Rb * K + C) * 2u; }
    const size_t kstep = (size_t)(BK * 2);
    const size_t hstep = (size_t)HALF * K * 2;
    const size_t tstep = 2 * hstep;
    const unsigned ldsw = (unsigned)wid * 1024u;
    const int aoff = lds_byte(wr * 64 + fr, fq * 8), boff = lds_byte(wc * 32 + fr, fq * 8);
#define PG8_SA(b, h) (((b) * 2 + (h)) * HTB)
#define PG8_SB(b, h) ((4 + (b) * 2 + (h)) * HTB)
#define PG8_STAGE(bufoff, gbase, voff) do { _Pragma("unroll") for (int _i = 0; _i < 2; ++_i) \
        __builtin_amdgcn_global_load_lds((const unsigned*)((const char*)(gbase) + (voff)[_i]), (PG8_LAS unsigned*)(lds + (bufoff) + ldsw + _i * 8192), 16, 0, 0); } while (0)
#define PG8_LDA(dst, b, h) do { _Pragma("unroll") for (int m = 0; m < 4; ++m) _Pragma("unroll") for (int k = 0; k < 2; ++k) dst[m][k] = *(const PG8_LAS bf16x8*)(lds + PG8_SA(b, h) + aoff + m * 2048 + k * 1024); } while (0)
#define PG8_LDB(dst, b, h) do { _Pragma("unroll") for (int n = 0; n < 2; ++n) _Pragma("unroll") for (int k = 0; k < 2; ++k) dst[n][k] = *(const PG8_LAS bf16x8*)(lds + PG8_SB(b, h) + boff + n * 2048 + k * 1024); } while (0)
#define PG8_MMA(ai, bj, At, Bt) do { __builtin_amdgcn_s_setprio(1); _Pragma("unroll") for (int m = 0; m < 4; ++m) _Pragma("unroll") for (int n = 0; n < 2; ++n) _Pragma("unroll") for (int k = 0; k < 2; ++k) \
        acc[ai][bj][m][n] = __builtin_amdgcn_mfma_f32_16x16x32_bf16(Bt[n][k], At[m][k], acc[ai][bj][m][n], 0, 0, 0); __builtin_amdgcn_s_setprio(0); } while (0)
#define PG8_WAIT_V(n) asm volatile("s_waitcnt vmcnt(" #n ")" ::: "memory")
#define PG8_WAIT_L(n) asm volatile("s_waitcnt lgkmcnt(" #n ")" ::: "memory")
#define PG8_BAR __builtin_amdgcn_s_barrier()
#define PG8_SCHED __builtin_amdgcn_sched_barrier(0)
    Unit cur, nxt; int ui = 0;
    if (!S.next(0, cur)) return;
    f32x4 acc[2][2][4][2];
#pragma unroll
    for (int a = 0; a < 2; ++a)
#pragma unroll
        for (int b = 0; b < 2; ++b)
#pragma unroll
            for (int m = 0; m < 4; ++m)
#pragma unroll
                for (int n = 0; n < 2; ++n) acc[a][b][m][n] = (f32x4){0.f, 0.f, 0.f, 0.f};
    bf16x8 At[4][2], B0[2][2], B1[2][2];
    const char* cA = (const char*)g.A + (size_t)cur.pm * tstep; const char* cB = (const char*)g.Bt + (size_t)cur.pn * tstep;
    S.a_ready(cur);
    if constexpr (SP2) {
        PG8_STAGE(PG8_SB(0, 0), cB, voffB); PG8_STAGE(PG8_SB(0, 1), cB + hstep, voffB); PG8_STAGE(PG8_SA(0, 0), cA, voffA); PG8_STAGE(PG8_SA(0, 1), cA + hstep, voffA);
        if (wr == 1) PG8_BAR;
        PG8_WAIT_V(2); PG8_BAR;
        PG8_STAGE(PG8_SB(1, 0), cB + kstep, voffB); PG8_STAGE(PG8_SA(1, 0), cA + kstep, voffA); PG8_STAGE(PG8_SB(1, 1), cB + hstep + kstep, voffB);
        PG8_WAIT_V(6); PG8_BAR;
    } else {
        PG8_STAGE(PG8_SB(0, 0), cB, voffB); PG8_STAGE(PG8_SA(0, 0), cA, voffA); PG8_STAGE(PG8_SB(0, 1), cB + hstep, voffB); PG8_STAGE(PG8_SA(0, 1), cA + hstep, voffA);
        if (wr == 1) PG8_BAR;
        PG8_WAIT_V(4); PG8_BAR;
        PG8_STAGE(PG8_SB(1, 0), cB + kstep, voffB); PG8_STAGE(PG8_SA(1, 0), cA + kstep, voffA); PG8_STAGE(PG8_SB(1, 1), cB + hstep + kstep, voffB);
        PG8_WAIT_V(6); PG8_BAR;
    }
    for (;;) {
        const bool has_next = S.next(ui + 1, nxt);
        const char* nA = has_next ? (const char*)g.A + (size_t)nxt.pm * tstep : cA; const char* nB = has_next ? (const char*)g.Bt + (size_t)nxt.pn * tstep : cB;
        for (int t = 0; t < nt; t += 2) {
            const bool last = (t == nt - 2);
            const char* a1 = cA + (size_t)(t + 1) * kstep;
            const char* a2 = last ? nA : cA + (size_t)(t + 2) * kstep; const char* b2 = last ? nB : cB + (size_t)(t + 2) * kstep;
            const char* a3 = a2 + kstep; const char* b3 = b2 + kstep;
            if (last && has_next) S.a_ready(nxt);
            if constexpr (SP2) {
            PG8_LDB(B0, 0, 0); PG8_LDB(B1, 0, 1); PG8_SCHED; PG8_LDA(At, 0, 0); PG8_STAGE(PG8_SA(1, 1), a1 + hstep, voffA);
            PG8_WAIT_V(8); PG8_WAIT_L(0); PG8_BAR; PG8_MMA(0, 0, At, B0); PG8_MMA(0, 1, At, B1); PG8_BAR; PG8_SCHED;
            PG8_LDA(At, 0, 1); PG8_STAGE(PG8_SB(0, 0), b2, voffB); PG8_STAGE(PG8_SB(0, 1), b2 + hstep, voffB); PG8_STAGE(PG8_SA(0, 0), a2, voffA);
            PG8_WAIT_V(8); PG8_WAIT_L(0); PG8_BAR; PG8_MMA(1, 0, At, B0); PG8_MMA(1, 1, At, B1); PG8_BAR; PG8_SCHED;
            PG8_LDB(B0, 1, 0); PG8_LDB(B1, 1, 1); PG8_SCHED; PG8_LDA(At, 1, 0); PG8_STAGE(PG8_SA(0, 1), a2 + hstep, voffA);
            PG8_WAIT_V(8); PG8_WAIT_L(0); PG8_BAR; PG8_MMA(0, 0, At, B0); PG8_MMA(0, 1, At, B1); PG8_BAR; PG8_SCHED;
            PG8_LDA(At, 1, 1); PG8_STAGE(PG8_SB(1, 0), b3, voffB); PG8_STAGE(PG8_SB(1, 1), b3 + hstep, voffB); PG8_STAGE(PG8_SA(1, 0), a3, voffA);
            PG8_WAIT_V(8); PG8_WAIT_L(0); PG8_BAR; PG8_MMA(1, 0, At, B0); PG8_MMA(1, 1, At, B1); PG8_BAR; PG8_SCHED;
            } else {
            PG8_LDB(B0, 0, 0); PG8_SCHED; PG8_LDA(At, 0, 0); PG8_STAGE(PG8_SA(1, 1), a1 + hstep, voffA);
            PG8_WAIT_L(8); PG8_BAR; PG8_WAIT_L(0); PG8_MMA(0, 0, At, B0); PG8_BAR; PG8_SCHED;
            PG8_LDB(B1, 0, 1); PG8_STAGE(PG8_SB(0, 0), b2, voffB);
            PG8_BAR; PG8_WAIT_L(0); PG8_MMA(0, 1, At, B1); PG8_BAR;
            PG8_LDA(At, 0, 1); PG8_STAGE(PG8_SA(0, 0), a2, voffA);
            PG8_BAR; PG8_WAIT_L(0); PG8_MMA(1, 0, At, B0); PG8_BAR; PG8_SCHED;
            PG8_STAGE(PG8_SB(0, 1), b2 + hstep, voffB);
            PG8_WAIT_V(6); PG8_BAR; PG8_MMA(1, 1, At, B1); PG8_BAR;
            PG8_LDB(B0, 1, 0); PG8_SCHED; PG8_LDA(At, 1, 0); PG8_STAGE(PG8_SA(0, 1), a2 + hstep, voffA);
            PG8_WAIT_L(8); PG8_BAR; PG8_WAIT_L(0); PG8_MMA(0, 0, At, B0); PG8_BAR; PG8_SCHED;
            PG8_LDB(B1, 1, 1); PG8_STAGE(PG8_SB(1, 0), b3, voffB);
            PG8_BAR; PG8_WAIT_L(0); PG8_MMA(0, 1, At, B1); PG8_BAR;
            PG8_LDA(At, 1, 1); PG8_STAGE(PG8_SA(1, 0), a3, voffA);
            PG8_BAR; PG8_WAIT_L(0); PG8_MMA(1, 0, At, B0); PG8_BAR; PG8_SCHED;
            PG8_STAGE(PG8_SB(1, 1), b3 + hstep, voffB);
            PG8_WAIT_V(6); PG8_BAR; PG8_MMA(1, 1, At, B1); PG8_BAR;
            }
        }
        if constexpr (ALIGN_EPI) { if (wr == 0) PG8_BAR; }
        if constexpr (!Epi::AFTER_DRAIN) { E(acc, cur, wr, wc, fr, fq); S.done(cur); }
        if (!has_next) break;
#pragma unroll
        for (int a = 0; a < 2; ++a)
#pragma unroll
            for (int b = 0; b < 2; ++b)
#pragma unroll
                for (int m = 0; m < 4; ++m)
#pragma unroll
                    for (int n = 0; n < 2; ++n) acc[a][b][m][n] = (f32x4){0.f, 0.f, 0.f, 0.f};
        cur = nxt; cA = nA; cB = nB; ++ui;
        if constexpr (ALIGN_EPI) { if (wr == 1) PG8_BAR; }
    }
    PG8_WAIT_V(0);
    if constexpr (!ALIGN_EPI) { if (wr == 0) PG8_BAR; }
    PG8_BAR;
    if constexpr (Epi::AFTER_DRAIN) { E.fused(acc, cur, wr, wc, fr, fq, lds, wid, lane); S.done(cur); }
#undef PG8_SA
#undef PG8_SB
#undef PG8_STAGE
#undef PG8_LDA
#undef PG8_LDB
#undef PG8_MMA
#undef PG8_WAIT_V
#undef PG8_WAIT_L
#undef PG8_BAR
#undef PG8_SCHED
}
}
#ifndef MK_ONE_LAUNCH
#define MK_ONE_LAUNCH 1
#endif
constexpr int NWAVES = 8;
constexpr int DM = 1024, INW = 7168, BRW = 2048, MIXW = 1536, XW = 512;
constexpr int TOK = 49152, CH = 16384, NCH = 3;
constexpr int MEMROWS = 1280;
constexpr int NAH = 24, XH = 4;
constexpr int ZQ = 0, ZK = 1536, ZV = 3072, ZQM = 4608, ZG = 5120;
constexpr float RMS_EPS = 1e-6f;
constexpr size_t MiB = 1u << 20;
constexpr size_t WS_CTL = 0, CTL_ZERO_BYTES = 1 * MiB;
constexpr size_t WS_W1T = 2 * MiB;
constexpr size_t WS_W2T = 30 * MiB;
constexpr size_t WS_WKVT = 38 * MiB;
constexpr size_t WS_MEMN = 42 * MiB;
constexpr size_t WS_MKV = 47 * MiB;
constexpr size_t WS_KIMG = 52 * MiB;
constexpr size_t WS_VTIMG = 55 * MiB;
constexpr size_t WS_EDGE = 58 * MiB;
constexpr size_t WS_HB = 66 * MiB;
constexpr size_t WS_A = 162 * MiB;
constexpr size_t WS_YF = WS_A, WS_ZX = WS_A + 192 * MiB, WS_Z = WS_A, WS_Y = WS_A + 224 * MiB;
constexpr size_t WS_END = 450 * MiB;
constexpr int CW_BAR = 4096;
constexpr int RING_OFF = 0, RING_BYTES = 131072;
constexpr int LDSCTL_OFF = RING_BYTES, MISC_OFF = LDSCTL_OFF + 320;
constexpr int LDS_BYTES = 163840;
constexpr int PH_PREP = 0, PH_MKV = 1, PH_IMG = 2, PH_G1_0 = 3, PH_MIX_0 = 4, PH_G2_0 = 5, PH_NORM_0 = 6, PH_L1 = 7, PH_NORM_1 = 16, NPHASE = 17;
constexpr int XL_OFF = RING_BYTES + 1024;

#define GAS __attribute__((address_space(1)))
#define LAS __attribute__((address_space(3)))
typedef unsigned short bf16;
typedef unsigned v4u __attribute__((ext_vector_type(4)));
typedef float f32x4 __attribute__((ext_vector_type(4)));
typedef GAS unsigned gu32;
#define RLX_AGENT __ATOMIC_RELAXED, __HIP_MEMORY_SCOPE_AGENT
#define LDS_WAIT() asm volatile("s_waitcnt lgkmcnt(0)" ::: "memory")
__device__ __forceinline__ unsigned f2bf(float f) { unsigned u = __builtin_bit_cast(unsigned, f); return (u + 0x7fffu + ((u >> 16) & 1u)) >> 16; }
__device__ __forceinline__ unsigned pk2(float lo, float hi) { return f2bf(lo) | (f2bf(hi) << 16); }
__device__ __forceinline__ float bf2f(unsigned short b) { return __uint_as_float((unsigned)b << 16); }
__device__ __forceinline__ float bflo(unsigned w) { return __uint_as_float(w << 16); }
__device__ __forceinline__ float bfhi(unsigned w) { return __uint_as_float(w & 0xffff0000u); }
__device__ __forceinline__ float silu(float g) { return g / (1.0f + __expf(-g)); }
__device__ __forceinline__ float wave_sum(float v) {
#pragma unroll
    for (int o = 1; o < 64; o <<= 1) v += __shfl_xor(v, o);
    return v;
}
__device__ __forceinline__ float wave_max(float v) {
#pragma unroll
    for (int o = 1; o < 64; o <<= 1) v = fmaxf(v, __shfl_xor(v, o));
    return v;
}
template <int OFF> __device__ __forceinline__ unsigned long long karg64() {
    unsigned long long v; auto ka = __builtin_amdgcn_kernarg_segment_ptr();
    asm volatile("s_load_dwordx2 %0, %1, %2\n\ts_waitcnt lgkmcnt(0)" : "=s"(v) : "s"(ka), "i"(OFF) : "memory");
    return v;
}
#define XB_TMO      128
#define XB_XCNT(j)  (256  + 64 * (j))
#define XB_XSUB(j)  (1280 + 64 * (j))
#define XB_XGEN(j)  (2304 + 64 * (j))
#define XB_TOP      3328
#define XB_TOPGEN   3392
#define XCD_BAR_WORDS 3456
#define XB_SPIN_CAP (1u << 18)

__device__ __forceinline__ unsigned xb_ld(unsigned* p)              { return __hip_atomic_load(p, __ATOMIC_RELAXED, __HIP_MEMORY_SCOPE_AGENT); }
__device__ __forceinline__ unsigned xb_add(unsigned* p, unsigned v) { return __hip_atomic_fetch_add(p, v, __ATOMIC_RELAXED, __HIP_MEMORY_SCOPE_AGENT); }
__device__ __forceinline__ unsigned xb_xcc_id() { return (unsigned)__builtin_amdgcn_s_getreg((3 << 11) | 20) & 0xFu; }
#define XB_SPIN(cond, bar) do { unsigned _sp = 0; while (cond) { __builtin_amdgcn_s_sleep(1); \
    if ((++_sp & 255u) == 0u) { if (xb_ld(&(bar)[XB_TMO])) break; if (_sp > XB_SPIN_CAP) { atomicAdd(&(bar)[XB_TMO], 1u); break; } } } } while (0)

struct XcdBarrier {
    unsigned* bar; unsigned x;
    volatile LAS unsigned* st;
};

__device__ __forceinline__ XcdBarrier xcd_barrier_post(unsigned* bar, volatile LAS unsigned* st) {
    XcdBarrier b; b.bar = bar; b.x = xb_xcc_id(); b.st = st;
    if (threadIdx.x == 0) (void)xb_add(&bar[XB_XCNT(b.x)], 1u);
    return b;
}
__device__ __forceinline__ void xcd_barrier_complete(unsigned* bar, unsigned x, unsigned& nloc, unsigned& nx) {
    const unsigned G = gridDim.x * gridDim.y * gridDim.z;
    unsigned sum, cnt, mine, sp = 0u;
    for (;;) {
        sum = 0u; cnt = 0u; mine = 0u;
#pragma unroll
        for (unsigned j = 0; j < 16; ++j) { const unsigned c = xb_ld(&bar[XB_XCNT(j)]); sum += c; cnt += (c > 0u) ? 1u : 0u; mine = (j == x) ? c : mine; }
        if (sum == G) break;
        __builtin_amdgcn_s_sleep(1);
        if ((++sp & 255u) == 0u) { if (xb_ld(&bar[XB_TMO])) break; if (sp > XB_SPIN_CAP) { atomicAdd(&bar[XB_TMO], 1u); break; } }
    }
    nloc = mine > 0u ? mine : 1u; nx = cnt > 0u ? cnt : 1u;
}

__device__ __forceinline__ void xcd_barrier(const XcdBarrier& b) {
    asm volatile("s_waitcnt vmcnt(0)" ::: "memory");
    __syncthreads();
    if (threadIdx.x == 0) {
        unsigned* bar = b.bar;
        __builtin_amdgcn_s_waitcnt(0);
        unsigned nloc = b.st[0], nx = b.st[1];
        if (nloc == 0u) { xcd_barrier_complete(bar, b.x, nloc, nx); b.st[0] = nloc; b.st[1] = nx; }
        const unsigned old = xb_add(&bar[XB_XSUB(b.x)], 1u);
        const unsigned gen = old / nloc;
        if (old + 1u == (gen + 1u) * nloc) {
            __builtin_amdgcn_fence(__ATOMIC_RELEASE, "agent");
            asm volatile("s_waitcnt vmcnt(0)" ::: "memory");
            const unsigned og = xb_add(&bar[XB_TOP], 1u);
            const unsigned tg = og / nx;
            if (og + 1u == (tg + 1u) * nx) xb_add(&bar[XB_TOPGEN], 1u);
            else XB_SPIN(xb_ld(&bar[XB_TOPGEN]) == tg, bar);
            __builtin_amdgcn_fence(__ATOMIC_ACQUIRE, "agent");
            xb_add(&bar[XB_XGEN(b.x)], 1u);
            asm volatile("s_waitcnt vmcnt(0)" ::: "memory");
        } else {
            XB_SPIN(xb_ld(&bar[XB_XGEN(b.x)]) == gen, bar);
            __builtin_amdgcn_fence(__ATOMIC_ACQUIRE, "agent");
            asm volatile("s_waitcnt vmcnt(0)" ::: "memory");
        }
    }
    __syncthreads();
}
template <bool MAP0> __device__ __forceinline__ void transpose_item(const float* W, int K, int N, bf16* WT, LAS float* scr, int item, int lane) {
    const int nblk = N / 32, kb = item / nblk, nb = item % nblk, k0 = 64 * kb, n0 = 32 * nb;
    const int csrc = MAP0 ? pg8::origcol0(n0 + (lane & 31)) : n0 + (lane & 31);
#pragma unroll 8
    for (int i = 0; i < 32; ++i) { const int kk = 2 * i + (lane >> 5); scr[kk * 33 + (lane & 31)] = W[(size_t)(k0 + kk) * N + csrc]; }
    LDS_WAIT(); asm volatile("" ::: "memory");
    const int c = lane & 7;
#pragma unroll
    for (int j = 0; j < 4; ++j) { const int n = (lane >> 3) + 8 * j; const LAS float* s = scr + (8 * c) * 33 + n;
        v4u o; o.x = pk2(s[0 * 33], s[1 * 33]); o.y = pk2(s[2 * 33], s[3 * 33]); o.z = pk2(s[4 * 33], s[5 * 33]); o.w = pk2(s[6 * 33], s[7 * 33]);
        *(GAS v4u*)(WT + (size_t)(n0 + n) * K + k0 + 8 * c) = o; }
    LDS_WAIT(); asm volatile("" ::: "memory");
}
__device__ __forceinline__ void rms_row_to_bf16(const float* xrow, const float* w, bf16* orow, int lane) {
    const GAS f32x4* xr = (const GAS f32x4*)xrow + lane; const GAS f32x4* wr = (const GAS f32x4*)w + lane;
    f32x4 v[4]; float s = 0.f;
#pragma unroll
    for (int j = 0; j < 4; ++j) { v[j] = xr[64 * j]; s += (v[j].x * v[j].x + v[j].y * v[j].y) + (v[j].z * v[j].z + v[j].w * v[j].w); }
    const float rstd = 1.f / sqrtf(wave_sum(s) * (1.f / DM) + RMS_EPS);
    GAS unsigned long long* o8 = (GAS unsigned long long*)orow + lane;
#pragma unroll
    for (int j = 0; j < 4; ++j) { const f32x4 ww = wr[64 * j];
        o8[64 * j] = (unsigned long long)pk2(v[j].x * rstd * ww.x, v[j].y * rstd * ww.y) | ((unsigned long long)pk2(v[j].z * rstd * ww.z, v[j].w * rstd * ww.w) << 32); }
}
__device__ __forceinline__ void rms_row_to_f32(const float* xrow, const float* w, float* orow, int lane) {
    const GAS f32x4* xr = (const GAS f32x4*)xrow + lane; const GAS f32x4* wr = (const GAS f32x4*)w + lane;
    f32x4 v[4]; float s = 0.f;
#pragma unroll
    for (int j = 0; j < 4; ++j) { v[j] = xr[64 * j]; s += (v[j].x * v[j].x + v[j].y * v[j].y) + (v[j].z * v[j].z + v[j].w * v[j].w); }
    const float rstd = 1.f / sqrtf(wave_sum(s) * (1.f / DM) + RMS_EPS);
    GAS f32x4* o = (GAS f32x4*)orow + lane;
#pragma unroll
    for (int j = 0; j < 4; ++j) { const f32x4 ww = wr[64 * j]; o[64 * j] = (v[j] * rstd) * ww; }
}

struct Ptrs {
    const float *xp, *xs, *memp, *mems, *norm_w, *w_in, *w_out, *mem_norm_w, *w_mem_kv, *conv_w, *conv_b, *na_rpb, *final_norm_w;
    float* out;
    bf16 *W1T, *W2T, *WKVT, *MEMN, *MKV, *HB, *Y, *Z;
    unsigned char *KIMG, *VTIMG;
    bf16 *YF, *ZX; float* EDGE;
};

__device__ __forceinline__ void phase_prep(const Ptrs& P, LAS unsigned char* lds, int gw, int NGW, int wave, int lane) {
    LAS float* scr = (LAS float*)(lds + RING_OFF + wave * 16384);
    constexpr int I_W1 = (DM / 64) * (INW / 32), I_W2 = (BRW / 64) * (DM / 32), I_KV = (DM / 64) * (DM / 32);
    constexpr int NITEMS = 2 * (I_W1 + I_W2 + I_KV);
    for (int it = gw; it < NITEMS; it += NGW) {
        int r = it;
        if (r < I_W1) { transpose_item<true>(P.w_in, DM, INW, P.W1T, scr, r, lane); continue; } r -= I_W1;
        if (r < I_W1) { transpose_item<false>(P.w_in + (size_t)DM * INW, DM, INW, P.W1T + (size_t)INW * DM, scr, r, lane); continue; } r -= I_W1;
        if (r < 2 * I_W2) { const int l = r / I_W2; transpose_item<false>(P.w_out + (size_t)l * BRW * DM, BRW, DM, P.W2T + (size_t)l * DM * BRW, scr, r % I_W2, lane); continue; } r -= 2 * I_W2;
        { const int l = r / I_KV; transpose_item<false>(P.w_mem_kv + (size_t)l * DM * DM, DM, DM, P.WKVT + (size_t)l * DM * DM, scr, r % I_KV, lane); }
    }
    for (int m = gw; m < 2 * MEMROWS; m += NGW) { const int l = m / MEMROWS, r = m % MEMROWS;
        const float* src = (r < 1024) ? P.memp + (size_t)r * DM : P.mems + (size_t)(r - 1024) * DM;
        rms_row_to_bf16(src, P.mem_norm_w + l * DM, P.MEMN + (size_t)m * DM, lane); }
    for (int m = gw; m < TOK; m += NGW) { const float* src = (m < 32768) ? P.xp + (size_t)m * DM : P.xs + (size_t)(m - 32768) * DM;
        rms_row_to_bf16(src, P.norm_w, P.HB + (size_t)m * DM, lane); }
}

__device__ __forceinline__ void phase_conv(const Ptrs& P, int chunk, int gt, int NGT) {
    const int seqlen = (chunk == 2) ? 16384 : 8192;
    const bf16* z = P.Z; bf16* y = P.Y;
    for (int it = gt; it < CH * (MIXW / 8); it += NGT) {
        const int tl = it / (MIXW / 8), cg = it % (MIXW / 8), ch = cg * 8;
        const int ts = tl % seqlen; const bool hp = ts > 0, hn = ts < seqlen - 1;
        const bf16* zr = z + (size_t)tl * INW + ch;
        const v4u p0 = *(const GAS v4u*)(zr + ZQ), p1 = *(const GAS v4u*)(zr + ZK), p2 = *(const GAS v4u*)(zr + ZV), gg = *(const GAS v4u*)(zr + ZG);
        v4u a1 = (v4u){0, 0, 0, 0}, a2 = a1, b1 = a1, b2 = a1;
        if (hp) { a1 = *(const GAS v4u*)(zr - INW + ZK); a2 = *(const GAS v4u*)(zr - INW + ZV); }
        if (hn) { b1 = *(const GAS v4u*)(zr + INW + ZK); b2 = *(const GAS v4u*)(zr + INW + ZV); }
        float cw0[8], cw1[8], cw2[8], cb[8];
#pragma unroll
        for (int j = 0; j < 8; ++j) { cw0[j] = P.conv_w[ch + j]; cw1[j] = P.conv_w[MIXW + ch + j]; cw2[j] = P.conv_w[2 * MIXW + ch + j]; cb[j] = P.conv_b[ch + j]; }
        v4u o;
#pragma unroll
        for (int w = 0; w < 4; ++w) {
            float r[2];
#pragma unroll
            for (int e = 0; e < 2; ++e) {
                const int j = 2 * w + e;
                const float vp = e ? bfhi(a1[w]) * bfhi(a2[w]) : bflo(a1[w]) * bflo(a2[w]);
                const float vc = e ? bfhi(p1[w]) * bfhi(p2[w]) : bflo(p1[w]) * bflo(p2[w]);
                const float vn = e ? bfhi(b1[w]) * bfhi(b2[w]) : bflo(b1[w]) * bflo(b2[w]);
                const float conv = vp * cw0[j] + vc * cw1[j] + vn * cw2[j] + cb[j];
                const float b = e ? bfhi(p0[w]) : bflo(p0[w]);
                const float g = e ? bfhi(gg[w]) : bflo(gg[w]);
                r[e] = b * conv * silu(g);
            }
            o[w] = pk2(r[0], r[1]);
        }
        *(GAS v4u*)(y + (size_t)tl * BRW + ch) = o;
    }
}

__device__ __forceinline__ void phase_na_naive(const Ptrs& P, int chunk, int gw, int NGW, int lane) {
    const int seqlen = (chunk == 2) ? 16384 : 8192; const int rows = seqlen / 64;
    const bf16* z = P.Z; bf16* y = P.Y; const float* rpb = P.na_rpb;
    for (int task = gw; task < CH * NAH; task += NGW) {
        const int tl = task / NAH, h = task % NAH;
        const int ss = (tl / seqlen) * seqlen, ts = tl - ss, r = ts >> 6, c = ts & 63;
        int r0 = r - 4; r0 = r0 < 0 ? 0 : (r0 > rows - 8 ? rows - 8 : r0);
        int c0 = c - 8; c0 = c0 < 0 ? 0 : (c0 > 48 ? 48 : c0);
        v4u qv[8];
        { const GAS v4u* qp = (const GAS v4u*)(z + (size_t)tl * INW + ZQ + h * 64);
#pragma unroll
          for (int i = 0; i < 8; ++i) qv[i] = qp[i]; }
        float lg[2];
#pragma unroll
        for (int u = 0; u < 2; ++u) {
            const int kk = lane + 64 * u, a = kk >> 4, j = kk & 15;
            const int kt = ss + (r0 + a) * 64 + c0 + j;
            const GAS v4u* kp = (const GAS v4u*)(z + (size_t)kt * INW + ZK + h * 64);
            float dot = 0.f;
#pragma unroll
            for (int i = 0; i < 8; ++i) { const v4u kv = kp[i];
#pragma unroll
                for (int w = 0; w < 4; ++w) dot += bflo(qv[i][w]) * bflo(kv[w]) + bfhi(qv[i][w]) * bfhi(kv[w]); }
            lg[u] = dot * 0.125f + rpb[(h * 15 + (r0 + a - r + 7)) * 31 + (c0 + j - c + 15)];
        }
        const float mx = wave_max(fmaxf(lg[0], lg[1]));
        float pe[2]; pe[0] = __expf(lg[0] - mx); pe[1] = __expf(lg[1] - mx);
        const float inv = 1.f / wave_sum(pe[0] + pe[1]);
        pe[0] *= inv; pe[1] *= inv;
        float o = 0.f;
#pragma unroll
        for (int u = 0; u < 2; ++u)
            for (int kl = 0; kl < 64; ++kl) {
                const float p = __shfl(pe[u], kl);
                const int kk = kl + 64 * u, a = kk >> 4, j = kk & 15;
                const int kt = ss + (r0 + a) * 64 + c0 + j;
                o += p * bf2f(z[(size_t)kt * INW + ZV + h * 64 + lane]);
            }
        const float g = bf2f(z[(size_t)tl * INW + ZG + h * 64 + lane]);
        y[(size_t)tl * BRW + h * 64 + lane] = (bf16)f2bf(o * silu(g));
    }
}

__device__ __forceinline__ void phase_xattn_naive(const Ptrs& P, int layer, int chunk, int gw, int NGW, int lane) {
    const bf16* z = P.Z; bf16* y = P.Y;
    for (int task = gw; task < CH * XH; task += NGW) {
        const int tl = task / XH, h = task % XH;
        const int g = chunk * CH + tl, s = (g < 32768) ? (g >> 13) : 4;
        const bf16* kb = P.MKV + ((size_t)layer * MEMROWS + s * 256) * DM + h * 128;
        const bf16* vb = kb + 512;
        v4u qv[16];
        { const GAS v4u* qp = (const GAS v4u*)(z + (size_t)tl * INW + ZQM + h * 128);
#pragma unroll
          for (int i = 0; i < 16; ++i) qv[i] = qp[i]; }
        float lg[4];
#pragma unroll
        for (int u = 0; u < 4; ++u) {
            const int key = lane + 64 * u;
            const GAS v4u* kp = (const GAS v4u*)(kb + (size_t)key * DM);
            float dot = 0.f;
#pragma unroll
            for (int i = 0; i < 16; ++i) { const v4u kv = kp[i];
#pragma unroll
                for (int w = 0; w < 4; ++w) dot += bflo(qv[i][w]) * bflo(kv[w]) + bfhi(qv[i][w]) * bfhi(kv[w]); }
            lg[u] = dot * 0.08838834764831845f;
        }
        const float mx = wave_max(fmaxf(fmaxf(lg[0], lg[1]), fmaxf(lg[2], lg[3])));
        float pe[4]; float sm = 0.f;
#pragma unroll
        for (int u = 0; u < 4; ++u) { pe[u] = __expf(lg[u] - mx); sm += pe[u]; }
        const float inv = 1.f / wave_sum(sm);
        float o0 = 0.f, o1 = 0.f;
#pragma unroll
        for (int u = 0; u < 4; ++u)
            for (int kl = 0; kl < 64; ++kl) {
                const float p = __shfl(pe[u], kl) * inv;
                const unsigned vv = *(const GAS unsigned*)(vb + (size_t)(kl + 64 * u) * DM + 2 * lane);
                o0 += p * bflo(vv); o1 += p * bfhi(vv);
            }
        const unsigned gg = *(const GAS unsigned*)(z + (size_t)tl * INW + ZG + MIXW + h * 128 + 2 * lane);
        *(GAS unsigned*)(y + (size_t)tl * BRW + MIXW + h * 128 + 2 * lane) = pk2(o0 * silu(bflo(gg)), o1 * silu(bfhi(gg)));
    }
}

__device__ __forceinline__ void phase_edgefix(const Ptrs& P, int gt, int NGT) {
    for (int it = gt; it < 192 * 2 * (MIXW / 4); it += NGT) {
        const int c4 = it % (MIXW / 4), tw = it / (MIXW / 4), which = tw & 1, pm = tw >> 1, ch = c4 * 4;
        const int t = pm * 256 + (which ? 255 : 0), tn = which ? t + 1 : t - 1;
        const bool has = which ? (tn < TOK && !((tn % 8192 == 0) && tn <= 32768)) : !((t % 8192 == 0) && t <= 32768);
        const float* eb = P.EDGE + (size_t)pm * pg8::EDGE_TILE_FLOATS + (which ? 3 * MIXW : 0) + ch;
        const f32x4 pg = *(const GAS f32x4*)(eb), yp = *(const GAS f32x4*)(eb + 2 * MIXW);
        f32x4 y = yp;
        if (has) { const int pn_ = which ? pm + 1 : pm - 1;
            const f32x4 vn = *(const GAS f32x4*)(P.EDGE + (size_t)pn_ * pg8::EDGE_TILE_FLOATS + (which ? 0 : 3 * MIXW) + MIXW + ch);
            const f32x4 w = *(const GAS f32x4*)(P.conv_w + (which ? 2 * MIXW : 0) + ch);
            y = yp + pg * w * vn; }
        typedef unsigned u32x2 __attribute__((ext_vector_type(2)));
        u32x2 o; o.x = pk2(y[0], y[1]); o.y = pk2(y[2], y[3]);
        *(GAS u32x2*)(P.YF + (size_t)t * BRW + ch) = o;
    }
}
namespace xa {
typedef short bf16x8 __attribute__((ext_vector_type(8)));
typedef float f32x16 __attribute__((ext_vector_type(16)));
typedef float f32x2_t __attribute__((ext_vector_type(2))); typedef __bf16 bf16x2_t __attribute__((ext_vector_type(2)));
typedef unsigned u32x4 __attribute__((ext_vector_type(4)));
__device__ __forceinline__ int crow(int r, int h) { return (r & 3) + 8 * (r >> 2) + 4 * h; }
__device__ __forceinline__ unsigned cvtpk(float lo, float hi) { f32x2_t v = {lo, hi}; bf16x2_t b = __builtin_convertvector(v, bf16x2_t); return __builtin_bit_cast(unsigned, b); }
__device__ __forceinline__ int pos2key16(int p) { return 8 * ((p & 7) >> 2) + 4 * (p >> 3) + (p & 3); }
constexpr int XSCR_OFF = RING_BYTES + 1024;
constexpr float C2 = 0.08838834764831845f * 1.4426950408889634f;

__device__ __forceinline__ void xattn_unit(LAS unsigned char* lds, const bf16* qsrc, int qld, const bf16* gsrc, int gld, bf16* yd, int yld, int row0, const unsigned char* kimg, const unsigned char* vtimg, int tid) {
    const int lane = tid & 63, wid = __builtin_amdgcn_readfirstlane(tid >> 6), r32 = lane & 31, hh = lane >> 5;
    { const unsigned char* src = (wid < 4 ? kimg : vtimg - 65536) + (size_t)wid * 16384 + lane * 16;
#pragma unroll
      for (int i = 0; i < 16; ++i) __builtin_amdgcn_global_load_lds((const GAS unsigned*)(src + i * 1024), (LAS unsigned*)(lds + wid * 16384 + i * 1024), 16, 0, 0); }
    bf16x8 qf[8];
    { const bf16* qp = qsrc + (size_t)(row0 + wid * 32 + r32) * qld + hh * 8;
#pragma unroll
      for (int ks = 0; ks < 8; ++ks) qf[ks] = *(const GAS bf16x8*)(qp + ks * 16); }
    asm volatile("s_waitcnt vmcnt(0)" ::: "memory");
    __syncthreads();
    f32x16 s[8];
#pragma unroll
    for (int kb = 0; kb < 8; ++kb) {
        const int key = kb * 32 + r32;
        f32x16 acc;
#pragma unroll
        for (int i = 0; i < 16; ++i) acc[i] = 0.f;
#pragma unroll
        for (int ks = 0; ks < 8; ++ks) {
            const bf16x8 a = *(const LAS bf16x8*)(lds + key * 256 + (((2 * ks + hh) ^ (key & 15)) << 4));
            acc = __builtin_amdgcn_mfma_f32_32x32x16_bf16(a, qf[ks], acc, 0, 0, 0);
        }
        s[kb] = acc;
    }
    float m = s[0][0];
#pragma unroll
    for (int kb = 0; kb < 8; ++kb)
#pragma unroll
        for (int r = 0; r < 16; ++r) m = fmaxf(m, s[kb][r]);
    m = fmaxf(m, __shfl_xor(m, 32));
    const float mc = m * C2;
    float lsum = 0.f;
#pragma unroll
    for (int kb = 0; kb < 8; ++kb)
#pragma unroll
        for (int r = 0; r < 16; ++r) { const float p = __builtin_amdgcn_exp2f(s[kb][r] * C2 - mc); s[kb][r] = p; lsum += p; }
    lsum += __shfl_xor(lsum, 32);
    __syncthreads();
    f32x16 o[4];
#pragma unroll
    for (int db = 0; db < 4; ++db)
#pragma unroll
        for (int i = 0; i < 16; ++i) o[db][i] = 0.f;
#pragma unroll
    for (int kb = 0; kb < 8; ++kb)
#pragma unroll
        for (int st = 0; st < 2; ++st) {
            u32x4 pw;
#pragma unroll
            for (int j = 0; j < 4; ++j) pw[j] = cvtpk(s[kb][8 * st + 2 * j], s[kb][8 * st + 2 * j + 1]);
            const bf16x8 pa = __builtin_bit_cast(bf16x8, pw);
            const int c = 4 * kb + 2 * st + hh;
#pragma unroll
            for (int db = 0; db < 4; ++db) {
                const int d = db * 32 + r32;
                const bf16x8 b = *(const LAS bf16x8*)(lds + 65536 + d * 512 + ((((c & 15) ^ (d & 15)) | (c & 16)) << 4));
                o[db] = __builtin_amdgcn_mfma_f32_32x32x16_bf16(pa, b, o[db], 0, 0, 0);
            }
        }
    LAS float* lsc = (LAS float*)(lds + XSCR_OFF + wid * 128);
    if (hh == 0) lsc[r32] = lsum;
    asm volatile("s_waitcnt lgkmcnt(0)" ::: "memory");
    LAS bf16* stg = (LAS bf16*)(lds + wid * 8192);
#pragma unroll
    for (int r = 0; r < 16; ++r) {
        const int q = crow(r, hh); const float rl = 1.0f / lsc[q];
#pragma unroll
        for (int db = 0; db < 4; ++db) stg[q * 128 + db * 32 + r32] = (bf16)f2bf(o[db][r] * rl);
    }
    asm volatile("s_waitcnt lgkmcnt(0)" ::: "memory");
#pragma unroll
    for (int i = 0; i < 8; ++i) {
        const int idx = i * 64 + lane, row = idx >> 4, ch = idx & 15;
        const u32x4 ov = *(const LAS u32x4*)(stg + row * 128 + ch * 8);
        const size_t grow = (size_t)(row0 + wid * 32 + row);
        const u32x4 gv = *(const GAS u32x4*)(gsrc + grow * gld + ch * 8);
        u32x4 w;
#pragma unroll
        for (int j = 0; j < 4; ++j) w[j] = pk2(bflo(ov[j]) * silu(bflo(gv[j])), bfhi(ov[j]) * silu(bfhi(gv[j])));
        *(GAS u32x4*)(yd + grow * yld + ch * 8) = w;
    }
    __syncthreads();
}
}

__device__ __forceinline__ void phase_img(const bf16* MKV, unsigned char* KIMG, unsigned char* VTIMG, int gt, int NGT) {
    for (int it = gt; it < 40 * 4096; it += NGT) {
        const int img = it >> 12, key = (it >> 4) & 255, c = it & 15, ls = img >> 2, h = img & 3;
        const v4u v = *(const GAS v4u*)(MKV + ((size_t)ls * 256 + key) * DM + h * 128 + c * 8);
        *(GAS v4u*)(KIMG + (size_t)img * 65536 + key * 256 + ((c ^ (key & 15)) << 4)) = v;
    }
    for (int it = gt; it < 40 * 4096; it += NGT) {
        const int img = it >> 12, d = (it >> 5) & 127, c = it & 31, ls = img >> 2, h = img & 3;
        const bf16* vsrc = MKV + (size_t)ls * 256 * DM + 512 + h * 128 + d;
        unsigned short e[8];
#pragma unroll
        for (int j = 0; j < 8; ++j) { const int p = c * 8 + j, key = (p & ~15) + xa::pos2key16(p & 15); e[j] = vsrc[(size_t)key * DM]; }
        v4u v; v.x = e[0] | ((unsigned)e[1] << 16); v.y = e[2] | ((unsigned)e[3] << 16); v.z = e[4] | ((unsigned)e[5] << 16); v.w = e[6] | ((unsigned)e[7] << 16);
        *(GAS v4u*)(VTIMG + (size_t)img * 65536 + d * 512 + ((((c & 15) ^ (d & 15)) | (c & 16)) << 4)) = v;
    }
}
namespace na {
typedef short bf16x8 __attribute__((ext_vector_type(8)));
typedef short s16x4 __attribute__((ext_vector_type(4)));
typedef float f32x4 __attribute__((ext_vector_type(4)));
typedef unsigned u32x4 __attribute__((ext_vector_type(4)));
constexpr int V_OFF = 61440, RPB_OFF = RING_BYTES + 2048, STG_OFF = RING_BYTES + 12288;
constexpr float LOG2E = 1.4426950408889634f, QS = 0.125f * LOG2E;
__device__ __forceinline__ int clampi(int v, int lo, int hi) { return v < lo ? lo : (v > hi ? hi : v); }
__device__ __forceinline__ s16x4 vtr(unsigned addr) { return __builtin_bit_cast(s16x4, __builtin_amdgcn_ds_read_tr16_b64_v4i16((LAS s16x4*)addr)); }
struct UnitDesc { int seqstart, rows, band, cb, h; };
#define NA_BAR() do { asm volatile("s_waitcnt lgkmcnt(0)" ::: "memory"); __builtin_amdgcn_s_barrier(); asm volatile("" ::: "memory"); } while (0)

__device__ __forceinline__ void stage_image(LAS unsigned char* lds, const bf16* z, const UnitDesc& d, int which, int wid, int lane) {
    const int lo = clampi(d.band * 8 - 4, 0, d.rows - 15), kstart = clampi(16 * d.cb - 8, 0, 32);
    const int key8 = lane >> 3, cp = lane & 7;
    const bf16* zb = z + (size_t)(d.seqstart + lo * 64 + kstart) * INW + (which ? ZV : ZK) + d.h * 64;
#pragma unroll
    for (int j = 0; j < 8; ++j) {
        const int pp = wid + 8 * j;
        if (pp < 60) {
            const int a15 = pp >> 2, key = (pp & 3) * 8 + key8, sw = key >> 1;
            const int c = which ? ((((cp >> 1) ^ (sw & 3)) << 1) | (cp & 1)) : (cp ^ (sw & 7));
            __builtin_amdgcn_global_load_lds((const GAS unsigned*)(zb + (size_t)(a15 * 64 + key) * INW + c * 8), (LAS unsigned*)(lds + which * V_OFF + pp * 1024), 16, 0, 0);
        }
    }
}

constexpr int TBL_FLOATS = 720, TBL_BYTES = TBL_FLOATS * 4, NEGB = 465;
template <class Sched> __device__ __forceinline__ void na_phase(LAS unsigned char* lds, const bf16* z, bf16* y, const float* rpb, const Sched& S, int tid, int flags) {
    const int lane = tid & 63, wid = __builtin_amdgcn_readfirstlane(tid >> 6), l16 = lane & 15, g = lane >> 4;
    UnitDesc cur, nxt;
    if (!S.next(0, cur)) return;
    stage_image(lds, z, cur, 0, wid, lane); stage_image(lds, z, cur, 1, wid, lane);
    int tabh0 = -1, tabh1 = -1, tabh2 = -1;
    bf16x8 qf0, qf1; u32x4 gv[2];
    { const int r = cur.band * 8 + wid; const size_t qtok = (size_t)(cur.seqstart + r * 64 + cur.cb * 16 + l16);
      qf0 = *(const GAS bf16x8*)(z + qtok * INW + ZQ + cur.h * 64 + g * 8); qf1 = *(const GAS bf16x8*)(z + qtok * INW + ZQ + cur.h * 64 + 32 + g * 8);
#pragma unroll
      for (int i2 = 0; i2 < 2; ++i2) { const int idx = i2 * 64 + lane, q = idx >> 3, ch = idx & 7;
          gv[i2] = *(const GAS u32x4*)(z + (size_t)(cur.seqstart + r * 64 + cur.cb * 16 + q) * INW + ZG + cur.h * 64 + ch * 8); } }
    for (int ui = 0;; ++ui) {
        const bool has_next = S.next(ui + 1, nxt);
        const int r = cur.band * 8 + wid, h = cur.h, cb = cur.cb, rows = cur.rows;
        const int lo = clampi(cur.band * 8 - 4, 0, rows - 15), r0 = clampi(r - 4, 0, rows - 8), kstart = clampi(16 * cb - 8, 0, 32);
        const int slot = h % 3;
        { const int th = (slot == 0) ? tabh0 : (slot == 1) ? tabh1 : tabh2;
          if (th != h) {
              LAS float* tb = (LAS float*)(lds + RPB_OFF + slot * TBL_BYTES);
              for (int i = tid; i < TBL_FLOATS; i += NWAVES * 64) tb[i] = (i < NEGB) ? rpb[h * 465 + i] * 8.0f : -INFINITY;
              if (slot == 0) tabh0 = h; else if (slot == 1) tabh1 = h; else tabh2 = h; } }
        const int qcol = cb * 16 + l16, cs = clampi(qcol - 8, 0, 48), dyb = r0 - r + 7;
        unsigned tb_e[8];
#pragma unroll
        for (int e = 0; e < 8; ++e) { const int kcol = kstart + 16 * (e >> 2) + 4 * g + (e & 3); const bool v = (kcol >= cs) && (kcol < cs + 16);
            tb_e[e] = (unsigned)(uintptr_t)(lds + RPB_OFF + slot * TBL_BYTES) + 4u * (unsigned)(v ? dyb * 31 + (kcol - qcol + 15) : NEGB); }
        asm volatile("s_waitcnt vmcnt(0)" ::: "memory");
        NA_BAR();
        const int slot0 = r0 - lo;
        f32x4 s[8][2];
#pragma unroll
        for (int a = 0; a < 8; ++a)
#pragma unroll
            for (int cbk = 0; cbk < 2; ++cbk) {
                const int key = 16 * cbk + l16, sw = (key >> 1) & 7;
                LAS unsigned char* kb = lds + (slot0 + a) * 4096 + key * 128;
                const bf16x8 a0 = *(const LAS bf16x8*)(kb + ((g ^ sw) << 4)), a1 = *(const LAS bf16x8*)(kb + (((4 + g) ^ sw) << 4));
                f32x4 acc;
#pragma unroll
                for (int i = 0; i < 4; ++i) acc[i] = *(const LAS float*)(tb_e[cbk * 4 + i] + 124 * a);
                acc = __builtin_amdgcn_mfma_f32_16x16x32_bf16(a0, qf0, acc, 0, 0, 0);
                acc = __builtin_amdgcn_mfma_f32_16x16x32_bf16(a1, qf1, acc, 0, 0, 0);
                s[a][cbk] = acc;
            }
        NA_BAR();
        if (has_next) stage_image(lds, z, nxt, 0, wid, lane);
        float m = -INFINITY;
#pragma unroll
        for (int a = 0; a < 8; ++a)
#pragma unroll
            for (int cbk = 0; cbk < 2; ++cbk) m = fmaxf(fmaxf(m, fmaxf(s[a][cbk][0], s[a][cbk][1])), fmaxf(s[a][cbk][2], s[a][cbk][3]));
        m = fmaxf(m, __shfl_xor(m, 16)); m = fmaxf(m, __shfl_xor(m, 32));
        const float mq = m * QS;
        float lsum = 0.f;
#pragma unroll
        for (int a = 0; a < 8; ++a)
#pragma unroll
            for (int e = 0; e < 8; ++e) { const float p = __builtin_amdgcn_exp2f(s[a][e >> 2][e & 3] * QS - mq); s[a][e >> 2][e & 3] = p; lsum += p; }
        lsum += __shfl_xor(lsum, 16); lsum += __shfl_xor(lsum, 32);
        f32x4 o[4];
#pragma unroll
        for (int db = 0; db < 4; ++db) o[db] = (f32x4){0.f, 0.f, 0.f, 0.f};
        const int qq = l16 >> 2, pq = l16 & 3, klo = 4 * g + qq;
        const unsigned vlane = (unsigned)(uintptr_t)(lds + V_OFF) + klo * 128 + 8 * pq;
        const int vsw = (klo >> 1) & 3;
#pragma unroll
        for (int a = 0; a < 8; ++a) {
            u32x4 pw; pw[0] = xa::cvtpk(s[a][0][0], s[a][0][1]); pw[1] = xa::cvtpk(s[a][0][2], s[a][0][3]); pw[2] = xa::cvtpk(s[a][1][0], s[a][1][1]); pw[3] = xa::cvtpk(s[a][1][2], s[a][1][3]);
            const bf16x8 pa = __builtin_bit_cast(bf16x8, pw);
            const unsigned vb = vlane + (slot0 + a) * 4096;
#pragma unroll
            for (int db = 0; db < 4; ++db) {
                const s16x4 vl = vtr(vb + ((db ^ vsw) << 5)), vh = vtr(vb + 2048 + ((db ^ vsw) << 5));
                const bf16x8 b = (bf16x8){vl[0], vl[1], vl[2], vl[3], vh[0], vh[1], vh[2], vh[3]};
                o[db] = __builtin_amdgcn_mfma_f32_16x16x32_bf16(b, pa, o[db], 0, 0, 0);
            }
        }
        NA_BAR();
        if (has_next) stage_image(lds, z, nxt, 1, wid, lane);
        bf16x8 qn0 = qf0, qn1 = qf1; u32x4 gn[2] = {gv[0], gv[1]};
        if (has_next) { const int rn = nxt.band * 8 + wid; const size_t qtok = (size_t)(nxt.seqstart + rn * 64 + nxt.cb * 16 + l16);
            qn0 = *(const GAS bf16x8*)(z + qtok * INW + ZQ + nxt.h * 64 + g * 8); qn1 = *(const GAS bf16x8*)(z + qtok * INW + ZQ + nxt.h * 64 + 32 + g * 8);
#pragma unroll
            for (int i2 = 0; i2 < 2; ++i2) { const int idx = i2 * 64 + lane, q = idx >> 3, ch = idx & 7;
                gn[i2] = *(const GAS u32x4*)(z + (size_t)(nxt.seqstart + rn * 64 + nxt.cb * 16 + q) * INW + ZG + nxt.h * 64 + ch * 8); } }
        const float rl = 1.0f / lsum;
        LAS unsigned char* stg = lds + STG_OFF + wid * 2048;
        typedef unsigned u32x2 __attribute__((ext_vector_type(2)));
#pragma unroll
        for (int db = 0; db < 4; ++db) { u32x2 pk; pk.x = xa::cvtpk(o[db][0] * rl, o[db][1] * rl); pk.y = xa::cvtpk(o[db][2] * rl, o[db][3] * rl);
            *(LAS u32x2*)(stg + l16 * 128 + (((4 * db + g) ^ l16) << 3)) = pk; }
        asm volatile("s_waitcnt lgkmcnt(0)" ::: "memory");
#pragma unroll
        for (int i2 = 0; i2 < 2; ++i2) {
            const int idx = i2 * 64 + lane, q = idx >> 3, ch = idx & 7;
            u32x4 ov = *(const LAS u32x4*)(stg + q * 128 + (((2 * ch) ^ (q & 14)) << 3));
            if (q & 1) ov = (u32x4){ov.z, ov.w, ov.x, ov.y};
            const size_t tok = (size_t)(cur.seqstart + r * 64 + cb * 16 + q);
            u32x4 w;
#pragma unroll
            for (int j = 0; j < 4; ++j) w[j] = xa::cvtpk(bflo(ov[j]) * pg8::silu_f(bflo(gv[i2][j])), bfhi(ov[j]) * pg8::silu_f(bfhi(gv[i2][j])));
            *(GAS u32x4*)(y + tok * BRW + h * 64 + ch * 8) = w;
        }
        if (!has_next) break;
        cur = nxt; qf0 = qn0; qf1 = qn1; gv[0] = gn[0]; gv[1] = gn[1];
    }
    __syncthreads();
}
#undef NA_BAR
struct XcdOrder {
    int G, vcu, seqlen;
    __device__ __forceinline__ bool next(int i, UnitDesc& d) const {
        const int rows = seqlen / 64, bps = rows / 8;
        int b32, h, cb;
        if (G % 8 == 0 && G >= 8) { const int per = G / 8, x = vcu / per, j = vcu % per, e = i * per + j; if (e >= 384) return false; b32 = e / 12; const int rem = e % 12; h = 3 * x + (rem >> 2); cb = rem & 3; }
        else { const int u = i * G + vcu; if (u >= 3072) return false; cb = u & 3; h = (u >> 2) % NAH; b32 = (u >> 2) / NAH; }
        d.seqstart = (b32 / bps) * seqlen; d.rows = rows; d.band = b32 % bps; d.cb = cb; d.h = h; return true;
    }
};
}
struct Args { const float* in[13]; float* out; unsigned char* ws; int ph_lo, ph_hi, flags, pad; };
__global__ void __launch_bounds__(NWAVES * 64, 2) fwd_kernel(Args args) {
    extern __shared__ __attribute__((aligned(16))) unsigned char lds_raw[];
    LAS unsigned char* lds = (LAS unsigned char*)lds_raw;
    volatile LAS unsigned* MISC = (volatile LAS unsigned*)(lds + MISC_OFF);
#define KARG(off) karg64<(off)>()
#define LOAD_PTRS() Ptrs P; do { unsigned char* ws_ = (unsigned char*)(GAS unsigned char*)KARG(112); \
    P.xp = (const float*)(const GAS float*)KARG(0); P.xs = (const float*)(const GAS float*)KARG(8); P.memp = (const float*)(const GAS float*)KARG(16); P.mems = (const float*)(const GAS float*)KARG(24); P.norm_w = (const float*)(const GAS float*)KARG(32); \
    P.w_in = (const float*)(const GAS float*)KARG(40); P.w_out = (const float*)(const GAS float*)KARG(48); P.mem_norm_w = (const float*)(const GAS float*)KARG(56); P.w_mem_kv = (const float*)(const GAS float*)KARG(64); P.conv_w = (const float*)(const GAS float*)KARG(72); \
    P.conv_b = (const float*)(const GAS float*)KARG(80); P.na_rpb = (const float*)(const GAS float*)KARG(88); P.final_norm_w = (const float*)(const GAS float*)KARG(96); P.out = (float*)(GAS float*)KARG(104); \
    P.W1T = (bf16*)(ws_ + WS_W1T); P.W2T = (bf16*)(ws_ + WS_W2T); P.WKVT = (bf16*)(ws_ + WS_WKVT); P.MEMN = (bf16*)(ws_ + WS_MEMN); P.MKV = (bf16*)(ws_ + WS_MKV); \
    P.HB = (bf16*)(ws_ + WS_HB); P.Y = (bf16*)(ws_ + WS_Y); P.Z = (bf16*)(ws_ + WS_Z); P.KIMG = ws_ + WS_KIMG; P.VTIMG = ws_ + WS_VTIMG; P.YF = (bf16*)(ws_ + WS_YF); P.ZX = (bf16*)(ws_ + WS_ZX); P.EDGE = (float*)(ws_ + WS_EDGE); } while (0)
    for (int u = threadIdx.x; u < (LDS_BYTES - LDSCTL_OFF) / 4; u += NWAVES * 64) ((LAS unsigned*)(lds + LDSCTL_OFF))[u] = 0u;
    __syncthreads();
    const int lo = args.ph_lo, hi = args.ph_hi;
    if (hi - lo > 1) (void)xcd_barrier_post((unsigned*)((gu32*)((GAS unsigned char*)KARG(112) + WS_CTL) + CW_BAR), MISC + 8);

    for (int ph = lo; ph < hi; ++ph) {
        int tid = threadIdx.x; asm volatile("" : "+v"(tid));
        int bx = blockIdx.x; asm volatile("" : "+s"(bx));
        int G = gridDim.x; asm volatile("" : "+s"(G));
        const int lane = tid & 63, wave = __builtin_amdgcn_readfirstlane(tid >> 6);
        const int vcu = (G % 8 == 0) ? (bx % 8) * (G / 8) + bx / 8 : bx;
        const int gw = vcu * NWAVES + wave, NGW = G * NWAVES;
        const int gt = vcu * (NWAVES * 64) + tid, NGT = G * NWAVES * 64;
        LOAD_PTRS();
        if (ph == PH_PREP) {
            phase_prep(P, lds, gw, NGW, wave, lane);
        } else if (ph == PH_MKV) {
            for (int l = 0; l < 2; ++l) {
                pg8::Gemm g{P.MEMN + (size_t)l * MEMROWS * DM, P.WKVT + (size_t)l * DM * DM, MEMROWS, DM, DM};
                pg8::StaticOrder S; S.init(MEMROWS, DM, G, (bx + 128 * l) % G);
                pg8::EpiBf16<0> E{P.MKV + (size_t)l * MEMROWS * DM, DM, nullptr, 0, 0, 1.f};
                pg8::gemm_phase<pg8::EpiBf16<0>, pg8::StaticOrder, true, true>(lds + RING_OFF, g, S, E, tid);
            }
        } else if (ph == PH_IMG) {
            phase_img(P.MKV, P.KIMG, P.VTIMG, gt, NGT);
        } else if (ph == PH_G1_0) {
            pg8::Gemm g{P.HB, P.W1T, TOK, INW, DM};
            pg8::StaticOrder S; S.init(TOK, INW, G, bx);
            pg8::EpiConv E{P.YF, P.ZX, P.EDGE, P.conv_w, P.conv_b, lds + XL_OFF};
            pg8::gemm_phase<pg8::EpiConv, pg8::StaticOrder, true, true>(lds + RING_OFF, g, S, E, tid);
        } else if (ph == PH_MIX_0) {
            phase_edgefix(P, gt, NGT);
            for (int u = vcu; u < (TOK / 256) * XH; u += G) {
                const int pm = u >> 2, h = u & 3, grow = pm * 256, seq = (grow < 32768) ? (grow >> 13) : 4, img = seq * 4 + h;
                xa::xattn_unit(lds, P.ZX + h * 128, 1024, P.ZX + 512 + h * 128, 1024, P.YF + MIXW + h * 128, BRW, grow, P.KIMG + (size_t)img * 65536, P.VTIMG + (size_t)img * 65536, tid);
            }
        } else if (ph == PH_G2_0) {
            pg8::Gemm g{P.YF, P.W2T, TOK, DM, BRW};
            pg8::StaticOrder S; S.init(TOK, DM, G, bx);
            pg8::EpiRes2 E{P.xp, P.xs, P.out, 128};
            pg8::gemm_phase<pg8::EpiRes2, pg8::StaticOrder, true, true>(lds + RING_OFF, g, S, E, tid);
        } else if (ph == PH_NORM_0) {
            for (int m = gw; m < TOK; m += NGW) rms_row_to_bf16(P.out + (size_t)m * DM, P.norm_w + DM, P.HB + (size_t)m * DM, lane);
        } else if (ph == PH_NORM_1) {
            for (int m = gw; m < TOK; m += NGW) rms_row_to_f32(P.out + (size_t)m * DM, P.final_norm_w, P.out + (size_t)m * DM, lane);
        } else {
            const int r = ph - PH_L1, chunk = r / 3, kind = r % 3;
            if (kind == 0) {
                pg8::Gemm g{P.HB + (size_t)chunk * CH * DM, P.W1T + (size_t)INW * DM, CH, INW, DM};
                pg8::StaticOrder S; S.init(CH, INW, G, bx);
                pg8::EpiBf16<0> E{P.Z, INW, nullptr, 0, 0, 1.f};
                pg8::gemm_phase<pg8::EpiBf16<0>, pg8::StaticOrder, true, true>(lds + RING_OFF, g, S, E, tid);
            } else if (kind == 1) {
                { na::XcdOrder S{G, vcu, (chunk == 2) ? 16384 : 8192}; na::na_phase(lds, P.Z, P.Y, P.na_rpb, S, tid, args.flags); }
#if defined(PROBE_MODE)
                if (!((args.flags >> 5) & 1))
#endif
                for (int u = vcu; u < (CH / 256) * XH; u += G) {
                    const int pm = u >> 2, h = u & 3, grow = chunk * CH + pm * 256, seq = (grow < 32768) ? (grow >> 13) : 4, img = (5 + seq) * 4 + h;
                    xa::xattn_unit(lds, P.Z + ZQM + h * 128, INW, P.Z + ZG + MIXW + h * 128, INW, P.Y + MIXW + h * 128, BRW, pm * 256, P.KIMG + (size_t)img * 65536, P.VTIMG + (size_t)img * 65536, tid);
                }
            } else {
                pg8::Gemm g{P.Y, P.W2T + (size_t)DM * BRW, CH, DM, BRW};
                pg8::StaticOrder S; S.init(CH, DM, G, bx);
                pg8::EpiRes2 E{P.out + (size_t)chunk * CH * DM, P.out + (size_t)chunk * CH * DM, P.out + (size_t)chunk * CH * DM, 1 << 20};
                pg8::gemm_phase<pg8::EpiRes2, pg8::StaticOrder, true, true>(lds + RING_OFF, g, S, E, tid);
            }
        }
        if (ph + 1 < hi) { XcdBarrier bar; bar.bar = (unsigned*)((gu32*)((GAS unsigned char*)KARG(112) + WS_CTL) + CW_BAR); bar.x = xb_xcc_id(); bar.st = MISC + 8; xcd_barrier(bar); }
    }
}

extern "C" void kernel_launch(void* const* d_in, const int* in_sizes, int n_in, void* d_out, int out_size, void* d_ws, size_t ws_size, hipStream_t stream) {
    static int grid = 0;
    if (grid == 0) {
        if (n_in != 13 || out_size != TOK * DM || ws_size < WS_END) { fprintf(stderr, "kernel_launch: unexpected shapes (n_in %d out %d ws %zu)\n", n_in, out_size, ws_size); grid = -1; return; }
        int dev = 0, cus = 0, per_cu = 0;
        if (hipGetDevice(&dev) != hipSuccess || hipDeviceGetAttribute(&cus, hipDeviceAttributeMultiprocessorCount, dev) != hipSuccess) { grid = -1; return; }
        if (hipFuncSetAttribute((const void*)fwd_kernel, hipFuncAttributeMaxDynamicSharedMemorySize, LDS_BYTES) != hipSuccess) { fprintf(stderr, "kernel_launch: hipFuncSetAttribute failed\n"); grid = -1; return; }
        if (hipOccupancyMaxActiveBlocksPerMultiprocessor(&per_cu, (const void*)fwd_kernel, NWAVES * 64, LDS_BYTES) != hipSuccess || per_cu < 1) { fprintf(stderr, "kernel_launch: occupancy query says %d\n", per_cu); per_cu = 1; }
        (void)hipGetLastError();
        grid = cus;
    }
    if (grid < 0) return;
    (void)hipMemsetAsync((char*)d_ws + WS_CTL, 0, CTL_ZERO_BYTES, stream);
    Args a{};
    for (int i = 0; i < 13; ++i) a.in[i] = (const float*)d_in[i];
    a.out = (float*)d_out; a.ws = (unsigned char*)d_ws;
#if defined(PROBE_MODE)
    for (int ph = 0; ph < NPHASE; ++ph) {
        int reps = 1; const int r = ph - PH_L1, kind = r % 3;
        if (PROBE_MODE == 2 && ph == PH_G1_0) reps = PROBE_REPS;
        if (PROBE_MODE == 3 && ph == PH_MIX_0) reps = PROBE_REPS;
        if (PROBE_MODE == 4 && ph >= PH_L1 && ph < PH_NORM_1 && kind == 1) reps = PROBE_REPS;
        if (PROBE_MODE == 5 && ph == PH_G2_0) reps = PROBE_REPS;
        if (PROBE_MODE == 6 && (ph == PH_PREP || ph == PH_NORM_0)) reps = PROBE_REPS;
        if (PROBE_MODE == 7 && (ph == PH_MKV || ph == PH_IMG)) reps = PROBE_REPS;
        if (PROBE_MODE == 8 && ph >= PH_L1 && ph < PH_NORM_1 && kind == 0) reps = PROBE_REPS;
        if (PROBE_MODE >= 10 && ph >= PH_L1 && ph < PH_NORM_1 && kind == 1) { a.flags = PROBE_MODE - 10 + 32; a.ph_lo = ph; a.ph_hi = ph + 1; hipLaunchKernelGGL(fwd_kernel, dim3(grid), dim3(NWAVES * 64), LDS_BYTES, stream, a); a.flags = 0; }
        for (int i = 0; i < reps; ++i) { a.ph_lo = ph; a.ph_hi = ph + 1; hipLaunchKernelGGL(fwd_kernel, dim3(grid), dim3(NWAVES * 64), LDS_BYTES, stream, a); }
    }
#elif MK_ONE_LAUNCH
    a.ph_lo = 0; a.ph_hi = NPHASE;
    hipLaunchKernelGGL(fwd_kernel, dim3(grid), dim3(NWAVES * 64), LDS_BYTES, stream, a);
#else
    for (int ph = 0; ph < NPHASE; ++ph) { a.ph_lo = ph; a.ph_hi = ph + 1;
        hipLaunchKernelGGL(fwd_kernel, dim3(grid), dim3(NWAVES * 64), LDS_BYTES, stream, a); }
#endif
}
```
